# Optimizing an MI355X kernel written in HIP

```python
import math
import jax
import jax.numpy as jnp
from jax import lax
import numpy as np

D_MODEL = 1024
BATCH = 1
SEQ = 16384
DEPTH = 4

GRID_W = 64
CTX_LEN = 256
N_EVEN = (DEPTH + 1) // 2
N_ODD = DEPTH // 2
EPS = 1e-6

HG_WIDTH = D_MODEL // 2
HG_DK = 128
HG_HEADS = HG_WIDTH // HG_DK
HG_DV = HG_WIDTH // HG_HEADS
HG_CHUNK = 64
SG_WIDTH = D_MODEL // 2
SG_CHUNK = 128
SG_GROUPS = 4
SG_GDIM = SG_WIDTH // SG_GROUPS
EVEN_IN = 5 * HG_WIDTH + 2 * SG_WIDTH
EVEN_OUT = HG_WIDTH + SG_WIDTH
DA_HEADS = 8
DA_DH = D_MODEL // DA_HEADS // 2
DA_DV = 2 * DA_DH
DA_QKV = 2 * DA_HEADS * 2 * DA_DH + DA_HEADS * DA_DV
Q_BLOCK = 128
ROPE_BASE = 10000.0
ROPE_AXIS = DA_DH // 2
D_FF = 256 * ((8 * D_MODEL // 3 + 255) // 256)
N_EXPERTS = 8
TOP_K = 2
E_FF = 7 * D_MODEL // 2
MOE_BLOCK = 128

kernel_name = "hybrid_hgrn2_sgu_diffattn_moe_dit"

F32 = jnp.float32


def _rms(x, eps=EPS):
    xf = x.astype(F32)
    return xf * lax.rsqrt(jnp.mean(xf * xf, axis=-1, keepdims=True) + eps)


def _layernorm(x, g, b, eps=1e-5):
    xf = x.astype(F32)
    mu = jnp.mean(xf, axis=-1, keepdims=True)
    var = jnp.mean(jnp.square(xf - mu), axis=-1, keepdims=True)
    return (xf - mu) * lax.rsqrt(var + eps) * g.astype(F32) + b.astype(F32)


def _ada(cvec, w, b):
    m = jax.nn.silu(cvec) @ w + b
    return jnp.split(m, 6, axis=-1)


def _modulate(x, shift, scale):
    return (_rms(x) * (1.0 + scale.astype(F32)) + shift.astype(F32)).astype(x.dtype)


def _hgrn_gates(f_pre, lb):
    b, n, _ = f_pre.shape
    f = f_pre.astype(F32)
    lb = lb.astype(F32)
    log_f = jnp.log(lb + (1.0 - lb) * jax.nn.sigmoid(f))
    k = (1.0 - lb) * jax.nn.sigmoid(-f)
    shp = (b, n, HG_HEADS, HG_DK)
    return log_f.reshape(shp), k.reshape(shp)


def _hgrn_chunk_scan(q, log_f, k, v, s0):
    b, n, h, _ = q.shape
    dv = v.shape[-1]
    nc = n // HG_CHUNK

    def chunks(a):
        return a.reshape(b, nc, HG_CHUNK, h, a.shape[-1]).transpose(1, 0, 3, 2, 4)

    lower = jnp.tril(jnp.ones((HG_CHUNK, HG_CHUNK), dtype=bool))[:, :, None]

    def step(s, inp):
        qc, lc, kc, vc = inp
        cum = jnp.cumsum(lc, axis=2)
        rel = cum[:, :, :, None, :] - cum[:, :, None, :, :]
        decay = jnp.where(lower, jnp.exp(jnp.where(lower, rel, 0.0)), 0.0)
        scores = jnp.einsum('bhtk,bhtsk,bhsk->bhts', qc, decay, kc)
        tot = cum[:, :, -1, :]
        o = scores @ vc + jnp.einsum('bhtk,bhkv->bhtv', qc * jnp.exp(cum), s)
        s_new = jnp.exp(tot)[..., None] * s + jnp.einsum(
            'bhsk,bhsv->bhkv', kc * jnp.exp(tot[:, :, None, :] - cum), vc)
        return s_new, o

    s_fin, o = lax.scan(step, s0, (chunks(q), chunks(log_f), chunks(k), chunks(v)))
    return o.transpose(1, 0, 3, 2, 4).reshape(b, n, h, dv), s_fin


def _hgrn_bidir(q, f_fw, f_bw, i, lb_f, lb_b, s0_f, s0_b):
    b, n, _ = q.shape
    qh = jax.nn.silu(q.astype(F32)).reshape(b, n, HG_HEADS, HG_DK)
    vh = i.astype(F32).reshape(b, n, HG_HEADS, HG_DV)
    lf_f, k_f = _hgrn_gates(f_fw, lb_f)
    lf_b, k_b = _hgrn_gates(f_bw, lb_b)
    o_f, s_f = _hgrn_chunk_scan(qh, lf_f, k_f, vh, s0_f)
    rev = lambda a: jnp.flip(a, axis=1)
    o_b, s_b = _hgrn_chunk_scan(rev(qh), rev(lf_b), rev(k_b), rev(vh), s0_b)
    return o_f + rev(o_b), s_f, s_b


def _hgrn_readout(o, g, gain):
    b, n = o.shape[:2]
    gate = jax.nn.silu(g.astype(F32)).reshape(b, n, HG_HEADS, HG_DV)
    return (_rms(o) * gain.astype(F32) * gate).reshape(b, n, HG_WIDTH)


def _spatial_gate(u, v, ln_g, ln_b, sg_w, sg_b):
    b, n, _ = u.shape
    u = jax.nn.gelu(u.astype(F32), approximate=False)
    v = _layernorm(jax.nn.gelu(v.astype(F32), approximate=False), ln_g, ln_b)
    vg = v.reshape(b, n // SG_CHUNK, SG_CHUNK, SG_GROUPS, SG_GDIM)
    mixed = jnp.einsum('gts,bnsgc->bntgc', sg_w.astype(F32), vg)
    mixed = mixed + sg_b.astype(F32).T[None, None, :, :, None]
    return u * mixed.reshape(b, n, SG_WIDTH)


def _even_mixer(hx, hc, w_in, lb_f, lb_b, hg_g, ln_g, ln_b, sg_w, sg_b, w_out, need_ctx):
    splits = [HG_WIDTH * i for i in range(1, 6)] + [5 * HG_WIDTH + SG_WIDTH]
    qx, ffx, fbx, ix, gx, ux, vx = jnp.split(hx @ w_in, splits, axis=-1)
    qc, ffc, fbc, ic, gc, uc, vc = jnp.split(hc @ w_in, splits, axis=-1)
    zero = jnp.zeros((hx.shape[0], HG_HEADS, HG_DK, HG_DV), F32)
    o_ctx, s_f, s_b = _hgrn_bidir(qc, ffc, fbc, ic, lb_f, lb_b, zero, zero)
    o_lat, _, _ = _hgrn_bidir(qx, ffx, fbx, ix, lb_f, lb_b, s_f, s_b)

    def merge(o_hg, g, u, v):
        a = _hgrn_readout(o_hg, g, hg_g)
        s = _spatial_gate(u, v, ln_g, ln_b, sg_w, sg_b)
        return jnp.concatenate([a, s], axis=-1).astype(hx.dtype) @ w_out

    ox = merge(o_lat, gx, ux, vx)
    oc = merge(o_ctx, gc, uc, vc) if need_ctx else None
    return ox, oc


def _axial_rope_tables(n):
    rows = n // GRID_W
    row = jnp.repeat(jnp.arange(rows, dtype=F32), GRID_W)
    col = jnp.tile(jnp.arange(GRID_W, dtype=F32), rows)
    inv = 1.0 / (ROPE_BASE ** (jnp.arange(0, ROPE_AXIS, 2, dtype=F32) / ROPE_AXIS))
    ar = row[:, None] * inv
    ac = col[:, None] * inv
    ang = jnp.concatenate([ar, ar, ac, ac], axis=-1)
    return jnp.cos(ang), jnp.sin(ang)


def _apply_rope(x, cos, sin):
    xr = x.reshape(x.shape[:-1] + (2, 2, ROPE_AXIS // 2))
    rot = jnp.stack([-xr[..., 1, :], xr[..., 0, :]], axis=-2).reshape(x.shape)
    c = cos[None, :, None, None, :]
    s = sin[None, :, None, None, :]
    return (x.astype(F32) * c + rot.astype(F32) * s).astype(x.dtype)


def _diff_attend(q, k, v, lam):
    b, nq = q.shape[:2]
    nb = nq // Q_BLOCK
    scale = DA_DH ** -0.5
    qb = q.reshape(b, nb, Q_BLOCK, DA_HEADS, 2, DA_DH).transpose(1, 0, 2, 3, 4, 5)

    def one(qblk):
        s = jnp.einsum('bqhjd,bkhjd->bhjqk', qblk, k).astype(F32) * scale
        p = jax.nn.softmax(s, axis=-1)
        a = p[:, :, 0] - lam * p[:, :, 1]
        return jnp.einsum('bhqk,bkhv->bqhv', a.astype(v.dtype), v)

    o = lax.map(one, qb)
    return o.transpose(1, 0, 2, 3, 4).reshape(b, nq, DA_HEADS, DA_DV)


def _diff_attention(hx, hc, w_qkv, lam, subln_g, w_out, lam_init, cos, sin, need_ctx):
    def proj(h):
        b, n, _ = h.shape
        q, k, v = jnp.split(h @ w_qkv, [DA_HEADS * 2 * DA_DH, 2 * DA_HEADS * 2 * DA_DH], axis=-1)
        return (q.reshape(b, n, DA_HEADS, 2, DA_DH), k.reshape(b, n, DA_HEADS, 2, DA_DH),
                v.reshape(b, n, DA_HEADS, DA_DV))

    qx, kx, vx = proj(hx)
    qx = _apply_rope(qx, cos, sin)
    kx = _apply_rope(kx, cos, sin)
    qc, kc, vc = proj(hc)
    lf = lam.astype(F32)
    lam_full = jnp.exp(jnp.sum(lf[0] * lf[1])) - jnp.exp(jnp.sum(lf[2] * lf[3])) + lam_init
    k_all = jnp.concatenate([kc, kx], axis=1)
    v_all = jnp.concatenate([vc, vx], axis=1)

    def finish(o):
        b, n = o.shape[:2]
        o = _rms(o, 1e-5) * subln_g.astype(F32) * (1.0 - lam_init)
        return o.reshape(b, n, D_MODEL).astype(hx.dtype) @ w_out

    ox = finish(_diff_attend(qx, k_all, v_all, lam_full))
    oc = finish(_diff_attend(qc, kc, vc, lam_full)) if need_ctx else None
    return ox, oc


def _swiglu(h, wg, wu, wd):
    return (jax.nn.silu(h @ wg) * (h @ wu)) @ wd


def _moe_swiglu(h, w_router, w_gate, w_up, w_down):
    b, n, d = h.shape
    t = b * n
    hf = h.reshape(t, d)
    logits = (hf @ w_router).astype(F32)
    top_v, top_i = lax.top_k(logits, TOP_K)
    top_w = jax.nn.softmax(top_v, axis=-1)
    flat_e = top_i.reshape(-1)
    flat_w = top_w.reshape(-1)
    flat_tok = jnp.repeat(jnp.arange(t, dtype=jnp.int32), TOP_K)
    order = jnp.argsort(flat_e)
    sorted_e = flat_e[order]
    counts = jnp.bincount(flat_e, length=N_EXPERTS)
    padded = ((counts + MOE_BLOCK - 1) // MOE_BLOCK) * MOE_BLOCK
    grp_start = jnp.cumsum(counts) - counts
    pad_end = jnp.cumsum(padded)
    pad_start = pad_end - padded
    dest = pad_start[sorted_e] + jnp.arange(t * TOP_K) - grp_start[sorted_e]
    n_rows = ((t * TOP_K + MOE_BLOCK - 1) // MOE_BLOCK) * MOE_BLOCK + N_EXPERTS * MOE_BLOCK
    n_blocks = n_rows // MOE_BLOCK
    row_tok = jnp.zeros((n_rows,), jnp.int32).at[dest].set(flat_tok[order])
    row_w = jnp.zeros((n_rows,), F32).at[dest].set(flat_w[order])
    blk_start = jnp.arange(n_blocks) * MOE_BLOCK
    blk_e = jnp.minimum(jnp.sum(pad_end[None, :] <= blk_start[:, None], axis=1), N_EXPERTS - 1)

    def one(args):
        tok, e = args
        xb = hf[tok]
        return (jax.nn.silu(xb @ w_gate[e]) * (xb @ w_up[e])) @ w_down[e]

    out = lax.map(one, (row_tok.reshape(n_blocks, MOE_BLOCK), blk_e))
    out = out.reshape(n_rows, d) * row_w[:, None].astype(out.dtype)
    y = jnp.zeros((t, d), h.dtype).at[row_tok].add(out)
    return y.reshape(b, n, d)


def setup_inputs(seed: int = 0) -> dict:
    key = jax.random.key(seed)
    ks = jax.random.split(key, 26)
    D = D_MODEL

    def nrm(k, shape, scale):
        return jax.random.normal(k, shape, F32) * scale

    return {
        "x": nrm(ks[0], (BATCH, SEQ, D), 1.0),
        "c": nrm(ks[1], (BATCH, D), 1.0),
        "ctx": nrm(ks[2], (BATCH, CTX_LEN, D), 1.0),
        "c_ctx": nrm(ks[3], (D,), 1.0),
        "mod_w": nrm(ks[4], (DEPTH, D, 6 * D), D ** -0.5),
        "mod_b": nrm(ks[5], (DEPTH, 6 * D), 0.01),
        "hg_lb": nrm(ks[6], (2, N_EVEN, HG_WIDTH), 1.0),
        "ev_w_in": nrm(ks[7], (N_EVEN, D, EVEN_IN), D ** -0.5),
        "hg_norm_g": 1.0 + nrm(ks[8], (N_EVEN, HG_DV), 0.01),
        "sg_ln_g": 1.0 + nrm(ks[9], (N_EVEN, SG_WIDTH), 0.01),
        "sg_ln_b": nrm(ks[10], (N_EVEN, SG_WIDTH), 0.01),
        "sg_w": nrm(ks[11], (N_EVEN, SG_GROUPS, SG_CHUNK, SG_CHUNK), SG_CHUNK ** -0.5),
        "sg_b": 1.0 + nrm(ks[12], (N_EVEN, SG_GROUPS, SG_CHUNK), 0.01),
        "ev_w_out": nrm(ks[13], (N_EVEN, EVEN_OUT, D), EVEN_OUT ** -0.5),
        "da_w_qkv": nrm(ks[14], (N_ODD, D, DA_QKV), D ** -0.5),
        "da_lam": nrm(ks[15], (N_ODD, 4, DA_DH), 0.1),
        "da_subln_g": 1.0 + nrm(ks[16], (N_ODD, DA_DV), 0.01),
        "da_w_out": nrm(ks[17], (N_ODD, DA_HEADS * DA_DV, D), (DA_HEADS * DA_DV) ** -0.5),
        "ffn_w_gate": nrm(ks[18], (N_EVEN, D, D_FF), D ** -0.5),
        "ffn_w_up": nrm(ks[19], (N_EVEN, D, D_FF), D ** -0.5),
        "ffn_w_down": nrm(ks[20], (N_EVEN, D_FF, D), D_FF ** -0.5),
        "moe_w_router": nrm(ks[21], (N_ODD, D, N_EXPERTS), D ** -0.5),
        "moe_w_gate": nrm(ks[22], (N_ODD, N_EXPERTS, D, E_FF), D ** -0.5),
        "moe_w_up": nrm(ks[23], (N_ODD, N_EXPERTS, D, E_FF), D ** -0.5),
        "moe_w_down": nrm(ks[24], (N_ODD, N_EXPERTS, E_FF, D), E_FF ** -0.5),
        "final_g": 1.0 + nrm(ks[25], (D,), 0.01),
    }


def reference(x, c, ctx, c_ctx, mod_w, mod_b, hg_lb, ev_w_in, hg_norm_g, sg_ln_g, sg_ln_b,
              sg_w, sg_b, ev_w_out, da_w_qkv, da_lam, da_subln_g, da_w_out, ffn_w_gate,
              ffn_w_up, ffn_w_down, moe_w_router, moe_w_gate, moe_w_up, moe_w_down, final_g):
    n = x.shape[1]
    cos, sin = _axial_rope_tables(n)
    lb_sm = jax.nn.softmax(hg_lb.astype(F32), axis=1)
    lb_all = jnp.cumsum(lb_sm, axis=1) - lb_sm[:, :1]
    cx = ctx
    for layer in range(DEPTH):
        j = layer // 2
        last = layer == DEPTH - 1
        sh1, sc1, g1, sh2, sc2, g2 = _ada(c, mod_w[layer], mod_b[layer])
        csh1, csc1, cg1, csh2, csc2, cg2 = _ada(c_ctx, mod_w[layer], mod_b[layer])
        hx = _modulate(x, sh1[:, None], sc1[:, None])
        hc = _modulate(cx, csh1, csc1)
        if layer % 2 == 0:
            ox, oc = _even_mixer(hx, hc, ev_w_in[j], lb_all[0, j], lb_all[1, j], hg_norm_g[j],
                                 sg_ln_g[j], sg_ln_b[j], sg_w[j], sg_b[j], ev_w_out[j],
                                 not last)
            ffn = lambda h: _swiglu(h, ffn_w_gate[j], ffn_w_up[j], ffn_w_down[j])
        else:
            lam_init = 0.8 - 0.6 * math.exp(-0.3 * layer)
            ox, oc = _diff_attention(hx, hc, da_w_qkv[j], da_lam[j], da_subln_g[j], da_w_out[j],
                                     lam_init, cos, sin, not last)
            ffn = lambda h: _moe_swiglu(h, moe_w_router[j], moe_w_gate[j], moe_w_up[j],
                                        moe_w_down[j])
        x = x + g1[:, None] * ox
        x = x + g2[:, None] * ffn(_modulate(x, sh2[:, None], sc2[:, None]))
        if not last:
            cx = cx + cg1 * oc
            cx = cx + cg2 * ffn(_modulate(cx, csh2, csc2))
    return (_rms(x) * final_g.astype(F32)).astype(x.dtype)
```

```cpp
#ifdef CPU_SIM
#include "cpu_sim.h"
typedef void* hipStream_t;
#else
#include <hip/hip_runtime.h>
#include <cstdio>
#include <cstdint>
#endif
#include <cmath>

#ifndef SEQ_LEN
#define SEQ_LEN 16384
#endif
#ifndef N_LAUNCH_MODE
#define N_LAUNCH_MODE 0
#endif

typedef unsigned short bf16_t;
typedef short bf16x8 __attribute__((ext_vector_type(8)));
typedef short s16x4 __attribute__((ext_vector_type(4)));
typedef float f32x4 __attribute__((ext_vector_type(4)));
typedef float f32x2 __attribute__((ext_vector_type(2)));
typedef float f32x16 __attribute__((ext_vector_type(16)));
typedef unsigned u32x4 __attribute__((ext_vector_type(4)));
typedef unsigned u32x2 __attribute__((ext_vector_type(2)));

constexpr int D = 1024, SEQ = SEQ_LEN, CTX = 256, T = SEQ + CTX;
constexpr int GRID_W = 64;
constexpr int EVEN_IN = 3584, DFF = 2816, EFF = 3584, NEXP = 8, DQKV = 3072;
constexpr int HCH = 64, NCH = T / HCH, NCC = CTX / HCH;
constexpr int SGC = 128, NSG = T / SGC;
constexpr int NR_MAX = ((2 * T + NEXP * 255 + 255) / 256) * 256;
constexpr int NTR_MAX = NR_MAX / 256;
constexpr int NWAVES = 8, NTHR = 512;
constexpr float QSCALE = 0.125f * 1.4426950408889634f;

constexpr size_t MiB = 1u << 20;
constexpr size_t al1(size_t x) { return (x + MiB - 1) / MiB * MiB; }
constexpr size_t WS_CTL = 0, CTL_BYTES = 1 * MiB;
constexpr size_t WS_SMALL = WS_CTL + CTL_BYTES;
constexpr size_t WS_TOK = WS_SMALL + 1 * MiB;
constexpr size_t WS_QN = WS_TOK + al1((size_t)T * 24);
constexpr size_t WS_HGD = WS_QN + al1((size_t)T * 32);
constexpr size_t WS_WIN = WS_HGD + al1((size_t)NCH * 8 * 512);
constexpr size_t SZ_WIN = (size_t)EVEN_IN * D * 2, SZ_WSQ = (size_t)D * D * 2, SZ_WGU = (size_t)2 * DFF * D * 2, SZ_WDN = (size_t)D * DFF * 2, SZ_WQKV = (size_t)DQKV * D * 2;
constexpr size_t WS_WEO = WS_WIN + 2 * SZ_WIN, WS_WGU = WS_WEO + 2 * SZ_WSQ, WS_WDN = WS_WGU + 2 * SZ_WGU, WS_WQKV = WS_WDN + 2 * SZ_WDN, WS_WAO = WS_WQKV + 2 * SZ_WQKV;
constexpr size_t WS_SGW = WS_WAO + 2 * SZ_WSQ;
constexpr size_t WS_MGU = al1(WS_SGW + 2 * 4 * 128 * 128 * 2);
constexpr size_t SZ_MGU = (size_t)NEXP * 2 * EFF * D * 2, SZ_MDN = (size_t)NEXP * D * EFF * 2;
constexpr size_t WS_MDN = WS_MGU + SZ_MGU;
constexpr size_t WS_X = al1(WS_MDN + SZ_MDN);
constexpr size_t WS_H = WS_X + al1((size_t)T * D * 4);
constexpr size_t WS_B = WS_H + al1((size_t)T * D * 2);
constexpr size_t WS_PROJ = WS_B;
constexpr size_t WS_HGU = WS_PROJ + al1((size_t)T * EVEN_IN * 2);
constexpr size_t WS_QR = WS_PROJ + al1((size_t)T * DQKV * 2);
constexpr size_t WS_KR = WS_QR + al1((size_t)T * D * 2);
constexpr size_t WS_MIX = WS_HGU + al1((size_t)NCH * 8 * 65536);
constexpr size_t WS_HFF = WS_B;
constexpr size_t WS_AG = WS_B;
constexpr size_t WS_HM = WS_AG + al1((size_t)NR_MAX * D * 2);
constexpr size_t WS_Y = WS_HM + al1((size_t)NR_MAX * EFF * 2);
constexpr size_t WS_END_A = WS_MIX + al1((size_t)T * D * 2), WS_END_B = WS_Y + al1((size_t)NR_MAX * D * 2);
constexpr size_t WS_END0 = WS_END_A > WS_END_B ? WS_END_A : WS_END_B;
constexpr size_t WS_HGS = WS_END0;
constexpr size_t WS_X1 = WS_HGS + al1((size_t)NCH * 8 * 65536);
constexpr size_t WS_END = WS_X1 + al1((size_t)T * D * 4);
static_assert(WS_KR + al1((size_t)T * D * 2) <= WS_MIX, "odd-layer q/k buffers below the mixer output");
constexpr int CW_BAR = 4096;
constexpr int CW_MOECNT = 8192, CW_MOECUR = 8192 + 128, CW_KMAX = 8192 + 256, CW_MOEWQ = 8192 + 384, CW_KB = 8192 + 512;
constexpr size_t SM_MODV = 0, SM_ROPE = 256 * 1024  , SM_LAMF = 512 * 1024, SM_MOETAB = 768 * 1024;

constexpr int LDS_MISC = 143360, LDS_BYTES = 147456;

#ifdef CPU_SIM
#define LAS
#define GAS
#define WAVE_SYNC() sim_wave_sync()
#define VM_WAIT()
static inline f32x16 mfma32(bf16x8 a, bf16x8 b, f32x16 c) { return sim_mfma32x32x16(a, b, c); }
static inline f32x4 mfma16(bf16x8 a, bf16x8 b, f32x4 c) { return sim_mfma16x16x32(a, b, c); }
static inline s16x4 ds_tr16(const unsigned char* p) { return sim_ds_read_tr16(p); }
static inline float fexp2(float x) { return exp2f(x); }
static inline float frcp(float x) { return 1.0f / x; }
static inline float frsq(float x) { return 1.0f / sqrtf(x); }
static inline int rfl(int x) { return x; }
#define OPAQUE(x) do {} while (0)
#define SETPRIO(n) do {} while (0)
#define BURN(x) do {} while (0)
#define SCHED_FENCE() do {} while (0)
static inline void glds16(const void* gsrc, unsigned char* wave_dst) { memcpy(wave_dst + (threadIdx.x & 63) * 16, gsrc, 16); }
static inline void glds16s(const void* sbase, unsigned voff, unsigned char* wave_dst) { memcpy(wave_dst + (threadIdx.x & 63) * 16, (const unsigned char*)sbase + voff, 16); }
#define WAIT_DMA_BAR() __syncthreads()
#define WAIT_DMA_BAR_KEEP() __syncthreads()
#else
#define LAS __attribute__((address_space(3)))
#define GAS __attribute__((address_space(1)))
#define WAVE_SYNC() asm volatile("s_waitcnt lgkmcnt(0)" ::: "memory")
#define VM_WAIT() asm volatile("s_waitcnt vmcnt(0)" ::: "memory")
typedef short v4i16_t __attribute__((ext_vector_type(4)));
__device__ __forceinline__ f32x16 mfma32(bf16x8 a, bf16x8 b, f32x16 c) { return __builtin_amdgcn_mfma_f32_32x32x16_bf16(a, b, c, 0, 0, 0); }
__device__ __forceinline__ f32x4 mfma16(bf16x8 a, bf16x8 b, f32x4 c) { return __builtin_amdgcn_mfma_f32_16x16x32_bf16(a, b, c, 0, 0, 0); }
__device__ __forceinline__ s16x4 ds_tr16(const LAS unsigned char* p) { return __builtin_bit_cast(s16x4, __builtin_amdgcn_ds_read_tr16_b64_v4i16((LAS v4i16_t*)p)); }
__device__ __forceinline__ float fexp2(float x) { return __builtin_amdgcn_exp2f(x); }
__device__ __forceinline__ float frcp(float x) { return __builtin_amdgcn_rcpf(x); }
__device__ __forceinline__ float frsq(float x) { return __builtin_amdgcn_rsqf(x); }
__device__ __forceinline__ int rfl(int x) { return __builtin_amdgcn_readfirstlane(x); }
#define OPAQUE(x) asm volatile("" : "+v"(x))
#define SETPRIO(n) __builtin_amdgcn_s_setprio(n)
#define BURN(x) do { float d_; asm volatile("v_exp_f32 %0, %1" : "=v"(d_) : "v"(x)); } while (0)
#define SCHED_FENCE() __builtin_amdgcn_sched_barrier(0)
__device__ __forceinline__ void glds16(const void* gsrc, LAS unsigned char* wave_dst) { unsigned keep; const unsigned d = (unsigned)__builtin_amdgcn_readfirstlane((int)(unsigned)(uintptr_t)wave_dst);
    asm volatile("s_mov_b32 %0, m0\n\ts_mov_b32 m0, %2\n\ts_nop 0\n\tglobal_load_lds_dwordx4 %1, off\n\ts_mov_b32 m0, %0" : "=&s"(keep) : "v"(gsrc), "s"(d) : "memory"); }
__device__ __forceinline__ void glds16s(const void* sbase, unsigned voff, LAS unsigned char* wave_dst) { unsigned keep; const unsigned d = (unsigned)__builtin_amdgcn_readfirstlane((int)(unsigned)(uintptr_t)wave_dst);
    asm volatile("s_mov_b32 %0, m0\n\ts_mov_b32 m0, %3\n\ts_nop 0\n\tglobal_load_lds_dwordx4 %1, %2\n\ts_mov_b32 m0, %0" : "=&s"(keep) : "v"(voff), "s"(sbase), "s"(d) : "memory"); }
#define WAIT_DMA_BAR() asm volatile("s_waitcnt vmcnt(0) lgkmcnt(0)\n\ts_barrier" ::: "memory")
#define WAIT_DMA_BAR_KEEP() asm volatile("s_waitcnt vmcnt(0)\n\ts_barrier" ::: "memory")
#endif

__device__ __forceinline__ unsigned f2bf(float f) { unsigned u = __builtin_bit_cast(unsigned, f); return (u + 0x7fffu + ((u >> 16) & 1u)) >> 16; }
#ifdef CPU_SIM
__device__ __forceinline__ unsigned pk2(float lo, float hi) { return f2bf(lo) | (f2bf(hi) << 16); }
#else
typedef __bf16 hw_bf16x2 __attribute__((ext_vector_type(2)));
__device__ __forceinline__ unsigned pk2(float lo, float hi) { const f32x2 v = {lo, hi}; return __builtin_bit_cast(unsigned, __builtin_convertvector(v, hw_bf16x2)); }
#endif
constexpr float F8_SH = 8.0f, F8_SW = 256.0f, F8_SM = 4.0f;
#ifdef CPU_SIM
static inline unsigned f2e4m3(float x) { unsigned sgn = x < 0 ? 0x80u : 0u; float ax = fabsf(x); if (!(ax == ax)) return sgn | 0x7fu; if (ax >= 448.f) return sgn | 0x7eu;
    if (ax < 0.015625f) { const int m = (int)rintf(ax * 512.f); return sgn | (unsigned)m; }
    int e; const float fr = frexpf(ax, &e); int m = (int)rintf(fr * 16.f); if (m == 16) { m = 8; ++e; } const int E = e - 1 + 7; if (E > 15 || (E == 15 && m - 8 > 6)) return sgn | 0x7eu; return sgn | (unsigned)(E << 3) | (unsigned)(m - 8); }
static inline float e4m32f(unsigned b) { const int E = (b >> 3) & 15, m = b & 7; float v = E == 0 ? ldexpf((float)m, -9) : ldexpf((float)(8 + m), E - 7 - 3); if (E == 15 && m == 7) v = NAN; return (b & 0x80u) ? -v : v; }
__device__ __forceinline__ unsigned pk4_f8(float a, float b, float c, float d) { return f2e4m3(a) | (f2e4m3(b) << 8) | (f2e4m3(c) << 16) | (f2e4m3(d) << 24); }
#else
__device__ __forceinline__ float f8clamp(float x) { return __builtin_amdgcn_fmed3f(x, -448.0f, 448.0f); }
__device__ __forceinline__ unsigned pk4_f8(float a, float b, float c, float d) { int w = 0; w = __builtin_amdgcn_cvt_pk_fp8_f32(f8clamp(a), f8clamp(b), w, false); w = __builtin_amdgcn_cvt_pk_fp8_f32(f8clamp(c), f8clamp(d), w, true); return (unsigned)w; }
#endif
__device__ __forceinline__ float bf2f(unsigned short b) { return __builtin_bit_cast(float, ((unsigned)b) << 16); }
__device__ __forceinline__ float bflo(unsigned w) { return __builtin_bit_cast(float, w << 16); }
__device__ __forceinline__ float bfhi(unsigned w) { return __builtin_bit_cast(float, w & 0xffff0000u); }
__device__ __forceinline__ float silu_f(float x) { return x * frcp(1.0f + __expf(-x)); }
__device__ __forceinline__ float sigm_f(float x) { return frcp(1.0f + __expf(-x)); }
__device__ __forceinline__ float gelu_f(float x) {
    const float t = frcp(fabsf(x) * 0.2316418882f + 1.0f);
    float q = t * 0.5307027145f + (-0.7265760135f); q = q * t + 0.7107068705f; q = q * t + (-0.142248368f); q = q * t + 0.127414796f; q = q * t;
    const float m = x * (q * fexp2(x * x * (-0.72134752044f)));
    return x < 0.f ? m : x - m;
}
#ifdef CPU_SIM
#define SHX(v, m, lane) __shfl_xor((v), (m))
#define SHI(v, src, lane) __shfl((v), (src))
#define SHC(v, srclane) __shfl((v), (srclane))
#define PARTNER32(v, lane) __shfl_xor((v), 32)
#else
__device__ __forceinline__ float shx_f(float v, int m, int lane) { return __builtin_bit_cast(float, __builtin_amdgcn_ds_bpermute((lane ^ m) << 2, __builtin_bit_cast(int, v))); }
__device__ __forceinline__ int shi_i(int v, int src) { return __builtin_amdgcn_ds_bpermute(src << 2, v); }
#define SHX(v, m, lane) shx_f((v), (m), (lane))
#define SHI(v, src, lane) shi_i((v), (src))
#define SHC(v, srclane) __builtin_bit_cast(float, __builtin_amdgcn_readlane(__builtin_bit_cast(int, (v)), (srclane)))
__device__ __forceinline__ float partner32_f(float v, int lane) { const unsigned u = __builtin_bit_cast(unsigned, v); auto r = __builtin_amdgcn_permlane32_swap(u, u, false, false); return __builtin_bit_cast(float, (lane & 32) ? r[0] : r[1]); }
#define PARTNER32(v, lane) partner32_f((v), (lane))
#endif
__device__ __forceinline__ float wave_sum(float v, int lane) {
#pragma unroll
    for (int o = 1; o < 64; o <<= 1) v += SHX(v, o, lane);
    return v;
}
#undef N_LAUNCH_MODE
#define N_LAUNCH_MODE 0
namespace pg8 {
#ifdef CPU_SIM
constexpr int BM = 256, BK = 64, HALF = 128, NXCD = 8, WGM = 8;
static int g_cur_phase = -1; static unsigned long long g_fp8_mask = 0; static float g_fp8_sa = 8.f, g_fp8_sb = 256.f;
static inline float q_e4m3(float x) { if (!(x == x)) return x; float ax = fabsf(x); if (ax >= 448.f) return x < 0 ? -448.f : 448.f; if (ax < 0.015625f) { float r = rintf(ax * 512.f) / 512.f; return x < 0 ? -r : r; } int e; frexpf(ax, &e); float ulp = ldexpf(1.f, e - 1 - 3); float r = rintf(ax / ulp) * ulp; if (r > 448.f) r = 448.f; return x < 0 ? -r : r; }
static float* g_qtab[2] = {nullptr, nullptr}; static float g_qtab_s[2] = {0.f, 0.f};
static inline const float* fp8_tab(int which, float s) { if (g_qtab[which] && g_qtab_s[which] == s) return g_qtab[which]; if (!g_qtab[which]) g_qtab[which] = (float*)malloc(65536 * 4); for (int i = 0; i < 65536; ++i) g_qtab[which][i] = q_e4m3(bf2f((bf16_t)i) * s) / s; g_qtab_s[which] = s; return g_qtab[which]; }
struct Unit { int pm, pn; };
struct Gemm { const bf16_t* A; const bf16_t* Bt; int M, N, K; };
struct StaticOrder {
    int nM, nN, nwg, G, c;
    void init(int M, int N, int G_, int c_) { nM = M / BM; nN = N / BM; nwg = nM * nN; G = G_; c = c_; }
    bool next(int i, Unit& u) const {
        const long L = (long)i * G + c; if (L >= nwg) return false;
        int wgid = (int)L; { const int q = nwg / NXCD, r = nwg % NXCD, xcd = wgid % NXCD, off = wgid / NXCD; wgid = (xcd < r ? xcd * (q + 1) : r * (q + 1) + (xcd - r) * q) + off; }
        const int nig = WGM * nN, gid = wgid / nig, fm = gid * WGM, gsz = (nM - fm) < WGM ? (nM - fm) : WGM;
        u.pm = fm + ((wgid % nig) % gsz); u.pn = (wgid % nig) / gsz; return true;
    }
    void a_ready(const Unit&) const {}
    void done(const Unit&) const {}
};
template <class Epi, class Sched, bool ALIGN_EPI = false, bool SP2 = false>
inline void gemm_phase(unsigned char* lds, const Gemm g, const Sched& S, const Epi& E, const int tid_in) {
    const int tid = threadIdx.x, wid = tid >> 6, lane = tid & 63, wr = wid >> 2, wc = wid & 3, fr = lane & 15, fq = lane >> 4;
    Unit cur;
    const bool f8 = g_cur_phase >= 0 && ((g_fp8_mask >> g_cur_phase) & 1ull); const float* qa = f8 ? fp8_tab(0, g_fp8_sa) : nullptr; const float* qb = f8 ? fp8_tab(1, g_fp8_sb) : nullptr;
    for (int ui = 0; S.next(ui, cur); ++ui) {
        f32x4 acc[2][2][4][2];
        for (int ai = 0; ai < 2; ++ai) for (int bj = 0; bj < 2; ++bj) for (int m = 0; m < 4; ++m) for (int n = 0; n < 2; ++n) for (int j = 0; j < 4; ++j) {
            const int r = 256 * cur.pm + 128 * ai + 64 * wr + 16 * m + fr;
            const int c = 256 * cur.pn + 128 * bj + 32 * wc + (Epi::PERM ? (8 * fq + 4 * n + j) : (16 * n + 4 * fq + j));
            const bf16_t* a = g.A + (size_t)r * g.K; const bf16_t* b = g.Bt + (size_t)c * g.K; float s = 0.f;
            if (Epi::F8) { const unsigned char* a8 = (const unsigned char*)g.A + (size_t)r * g.K * 2; const unsigned char* b8 = (const unsigned char*)g.Bt + (size_t)c * g.K * 2; for (int k = 0; k < 2 * g.K; ++k) s += e4m32f(a8[k]) * e4m32f(b8[k]); } else
            if (f8) { for (int k = 0; k < g.K; ++k) s += qa[a[k]] * qb[b[k]]; } else
            for (int k = 0; k < g.K; ++k) s += bf2f(a[k]) * bf2f(b[k]);
            acc[ai][bj][m][n][j] = s;
        }
        E(acc, cur, wr, wc, fr, fq);
    }
    __syncthreads();
}
#else
#define PG8_LAS __attribute__((address_space(3)))
constexpr int BM = 256, BK = 64, HALF = 128, HTB = HALF * BK * 2  , STAGE_BYTES = 8 * HTB, NXCD = 8, WGM = 8;

__host__ __device__ __forceinline__ int lds_byte(int r, int c) { const int st = (r >> 4) * 2 + (c >> 5), rr = r & 15, cc = c & 31, ob = rr * 64 + cc * 2; return st * 1024 + (ob ^ (((ob >> 9) & 1) << 5)); }
__host__ __device__ __forceinline__ void stage_rc(int b, int& R, int& C) { const int st = b / 1024, sb = b % 1024, swz = sb ^ (((sb >> 9) & 1) << 5); R = (st >> 1) * 16 + swz / 64; C = (st & 1) * 32 + (swz % 64) / 2; }
__host__ __device__ __forceinline__ int perm32(int rho) { const int n = rho >> 4, i = rho & 15; return 8 * (i >> 2) + 4 * n + (i & 3); }

struct Unit { int pm, pn; };
struct Gemm { const bf16_t* A; const bf16_t* Bt; int M, N, K; };

struct StaticOrder {
    int nM, nN, nwg, G, c;
    __host__ __device__ void init(int M, int N, int G_, int c_) { nM = M / BM; nN = N / BM; nwg = nM * nN; G = G_; c = c_; }
    __host__ __device__ bool next(int i, Unit& u) const {
        const long L = (long)i * G + c; if (L >= nwg) return false;
        int wgid = (int)L; { const int q = nwg / NXCD, r = nwg % NXCD, xcd = wgid % NXCD, off = wgid / NXCD; wgid = (xcd < r ? xcd * (q + 1) : r * (q + 1) + (xcd - r) * q) + off; }
        const int nig = WGM * nN, gid = wgid / nig, fm = gid * WGM, gsz = (nM - fm) < WGM ? (nM - fm) : WGM;
        u.pm = fm + ((wgid % nig) % gsz); u.pn = (wgid % nig) / gsz; return true;
    }
    __device__ __forceinline__ void a_ready(const Unit&) const {}
    __device__ __forceinline__ void done(const Unit&) const {}
};

typedef int pg8_i32x4 __attribute__((ext_vector_type(4))); typedef int pg8_i32x8 __attribute__((ext_vector_type(8)));
__device__ __forceinline__ pg8_i32x8 pg8_cat(bf16x8 lo, bf16x8 hi) { const pg8_i32x4 a = __builtin_bit_cast(pg8_i32x4, lo), b = __builtin_bit_cast(pg8_i32x4, hi); return __builtin_shufflevector(a, b, 0, 1, 2, 3, 4, 5, 6, 7); }
template <class Epi, class Sched, bool ALIGN_EPI = false, bool SP2 = false>
__device__ __forceinline__ void gemm_phase(PG8_LAS unsigned char* lds, const Gemm g, const Sched& S, const Epi& E, const int tid_in) {
    const int tid = tid_in, wid = __builtin_amdgcn_readfirstlane(tid >> 6), lane = tid & 63, wr = wid >> 2, wc = wid & 3, fr = lane & 15, fq = lane >> 4;
    const int K = g.K, nt = K / BK;
    unsigned voffA[2], voffB[2];
#pragma unroll
    for (int i = 0; i < 2; ++i) { int R, C; stage_rc(tid * 16 + i * 8192, R, C); const int Rb = Epi::PERM ? ((R & ~31) + perm32(R & 31)) : R;
        voffA[i] = (unsigned)(R * K + C) * 2u; voffB[i] = (unsigned)(Rb * K + C) * 2u; }
    const size_t kstep = (size_t)(BK * 2);
    const size_t hstep = (size_t)HALF * K * 2;
    const size_t tstep = 2 * hstep;
    const unsigned ldsw = (unsigned)wid * 1024u;
    const int aoff = lds_byte(wr * 64 + fr, fq * 8), boff = lds_byte(wc * 32 + fr, fq * 8);
#define PG8_SA(b, h) (((b) * 2 + (h)) * HTB)
#define PG8_SB(b, h) ((4 + (b) * 2 + (h)) * HTB)
#define PG8_STAGE(bufoff, gbase, voff) do { _Pragma("unroll") for (int _i = 0; _i < 2; ++_i) \
        __builtin_amdgcn_global_load_lds((const unsigned*)((const char*)(gbase) + (voff)[_i]), (PG8_LAS unsigned*)(lds + (bufoff) + ldsw + _i * 8192), 16, 0, 0); } while (0)
#define PG8_LDA(dst, b, h) do { _Pragma("unroll") for (int m = 0; m < 4; ++m) _Pragma("unroll") for (int k = 0; k < 2; ++k) dst[m][k] = *(const PG8_LAS bf16x8*)(lds + PG8_SA(b, h) + aoff + m * 2048 + k * 1024); } while (0)
#define PG8_LDB(dst, b, h) do { _Pragma("unroll") for (int n = 0; n < 2; ++n) _Pragma("unroll") for (int k = 0; k < 2; ++k) dst[n][k] = *(const PG8_LAS bf16x8*)(lds + PG8_SB(b, h) + boff + n * 2048 + k * 1024); } while (0)
#define PG8_MMA(ai, bj, At, Bt) do { __builtin_amdgcn_s_setprio(1); if constexpr (Epi::F8) { _Pragma("unroll") for (int m = 0; m < 4; ++m) _Pragma("unroll") for (int n = 0; n < 2; ++n) \
        asm volatile("v_mfma_f32_16x16x128_f8f6f4 %0, %1, %2, %0" : "+v"(acc[ai][bj][m][n]) : "v"(pg8_cat(Bt[n][0], Bt[n][1])), "v"(pg8_cat(At[m][0], At[m][1]))); } else { \
        _Pragma("unroll") for (int m = 0; m < 4; ++m) _Pragma("unroll") for (int n = 0; n < 2; ++n) _Pragma("unroll") for (int k = 0; k < 2; ++k) \
        acc[ai][bj][m][n] = __builtin_amdgcn_mfma_f32_16x16x32_bf16(Bt[n][k], At[m][k], acc[ai][bj][m][n], 0, 0, 0); } __builtin_amdgcn_s_setprio(0); } while (0)
#define PG8_WAIT_V(n) asm volatile("s_waitcnt vmcnt(" #n ")" ::: "memory")
#define PG8_WAIT_L(n) asm volatile("s_waitcnt lgkmcnt(" #n ")" ::: "memory")
#define PG8_BAR __builtin_amdgcn_s_barrier()
#define PG8_SCHED __builtin_amdgcn_sched_barrier(0)
    Unit cur, nxt; int ui = 0;
    if (!S.next(0, cur)) return;
    f32x4 acc[2][2][4][2];
#pragma unroll
    for (int a = 0; a < 2; ++a)
#pragma unroll
        for (int b = 0; b < 2; ++b)
#pragma unroll
            for (int m = 0; m < 4; ++m)
#pragma unroll
                for (int n = 0; n < 2; ++n) acc[a][b][m][n] = (f32x4){0.f, 0.f, 0.f, 0.f};
    bf16x8 At[4][2], B0[2][2], B1[2][2];
    const char* cA = (const char*)g.A + (size_t)cur.pm * tstep; const char* cB = (const char*)g.Bt + (size_t)cur.pn * tstep;
    S.a_ready(cur);
    if constexpr (SP2) {
        PG8_STAGE(PG8_SB(0, 0), cB, voffB); PG8_STAGE(PG8_SB(0, 1), cB + hstep, voffB); PG8_STAGE(PG8_SA(0, 0), cA, voffA); PG8_STAGE(PG8_SA(0, 1), cA + hstep, voffA);
        if (wr == 1) PG8_BAR;
        PG8_WAIT_V(2); PG8_BAR;
        PG8_STAGE(PG8_SB(1, 0), cB + kstep, voffB); PG8_STAGE(PG8_SA(1, 0), cA + kstep, voffA); PG8_STAGE(PG8_SB(1, 1), cB + hstep + kstep, voffB);
        PG8_WAIT_V(6); PG8_BAR;
    } else {
        PG8_STAGE(PG8_SB(0, 0), cB, voffB); PG8_STAGE(PG8_SA(0, 0), cA, voffA); PG8_STAGE(PG8_SB(0, 1), cB + hstep, voffB); PG8_STAGE(PG8_SA(0, 1), cA + hstep, voffA);
        if (wr == 1) PG8_BAR;
        PG8_WAIT_V(4); PG8_BAR;
        PG8_STAGE(PG8_SB(1, 0), cB + kstep, voffB); PG8_STAGE(PG8_SA(1, 0), cA + kstep, voffA); PG8_STAGE(PG8_SB(1, 1), cB + hstep + kstep, voffB);
        PG8_WAIT_V(6); PG8_BAR;
    }
    for (;;) {
        const bool has_next = S.next(ui + 1, nxt);
        const char* nA = has_next ? (const char*)g.A + (size_t)nxt.pm * tstep : cA; const char* nB = has_next ? (const char*)g.Bt + (size_t)nxt.pn * tstep : cB;
        _Pragma("nounroll") for (int t = 0; t < nt; t += 2) {
            const bool last = (t == nt - 2);
            const char* a1 = cA + (size_t)(t + 1) * kstep;
            const char* a2 = last ? nA : cA + (size_t)(t + 2) * kstep; const char* b2 = last ? nB : cB + (size_t)(t + 2) * kstep;
            const char* a3 = a2 + kstep; const char* b3 = b2 + kstep;
            if (last && has_next) S.a_ready(nxt);
            if constexpr (SP2) {
            PG8_LDB(B0, 0, 0); PG8_LDB(B1, 0, 1); PG8_SCHED; PG8_LDA(At, 0, 0); PG8_STAGE(PG8_SA(1, 1), a1 + hstep, voffA);
            PG8_WAIT_V(8); PG8_WAIT_L(0); PG8_BAR; PG8_MMA(0, 0, At, B0); PG8_MMA(0, 1, At, B1); PG8_BAR; PG8_SCHED;
            PG8_LDA(At, 0, 1); PG8_STAGE(PG8_SB(0, 0), b2, voffB); PG8_STAGE(PG8_SB(0, 1), b2 + hstep, voffB); PG8_STAGE(PG8_SA(0, 0), a2, voffA);
            PG8_WAIT_V(8); PG8_WAIT_L(0); PG8_BAR; PG8_MMA(1, 0, At, B0); PG8_MMA(1, 1, At, B1); PG8_BAR; PG8_SCHED;
            PG8_LDB(B0, 1, 0); PG8_LDB(B1, 1, 1); PG8_SCHED; PG8_LDA(At, 1, 0); PG8_STAGE(PG8_SA(0, 1), a2 + hstep, voffA);
            PG8_WAIT_V(8); PG8_WAIT_L(0); PG8_BAR; PG8_MMA(0, 0, At, B0); PG8_MMA(0, 1, At, B1); PG8_BAR; PG8_SCHED;
            PG8_LDA(At, 1, 1); PG8_STAGE(PG8_SB(1, 0), b3, voffB); PG8_STAGE(PG8_SB(1, 1), b3 + hstep, voffB); PG8_STAGE(PG8_SA(1, 0), a3, voffA);
            PG8_WAIT_V(8); PG8_WAIT_L(0); PG8_BAR; PG8_MMA(1, 0, At, B0); PG8_MMA(1, 1, At, B1); PG8_BAR; PG8_SCHED;
            } else {
            PG8_LDB(B0, 0, 0); PG8_SCHED; PG8_LDA(At, 0, 0); PG8_STAGE(PG8_SA(1, 1), a1 + hstep, voffA);
            PG8_WAIT_L(8); PG8_BAR; PG8_WAIT_L(0); PG8_MMA(0, 0, At, B0); PG8_BAR; PG8_SCHED;
            PG8_LDB(B1, 0, 1); PG8_STAGE(PG8_SB(0, 0), b2, voffB);
            PG8_BAR; PG8_WAIT_L(0); PG8_MMA(0, 1, At, B1); PG8_BAR;
            PG8_LDA(At, 0, 1); PG8_STAGE(PG8_SA(0, 0), a2, voffA);
            PG8_BAR; PG8_WAIT_L(0); PG8_MMA(1, 0, At, B0); PG8_BAR; PG8_SCHED;
            PG8_STAGE(PG8_SB(0, 1), b2 + hstep, voffB);
            PG8_WAIT_V(6); PG8_BAR; PG8_MMA(1, 1, At, B1); PG8_BAR;
            PG8_LDB(B0, 1, 0); PG8_SCHED; PG8_LDA(At, 1, 0); PG8_STAGE(PG8_SA(0, 1), a2 + hstep, voffA);
            PG8_WAIT_L(8); PG8_BAR; PG8_WAIT_L(0); PG8_MMA(0, 0, At, B0); PG8_BAR; PG8_SCHED;
            PG8_LDB(B1, 1, 1); PG8_STAGE(PG8_SB(1, 0), b3, voffB);
            PG8_BAR; PG8_WAIT_L(0); PG8_MMA(0, 1, At, B1); PG8_BAR;
            PG8_LDA(At, 1, 1); PG8_STAGE(PG8_SA(1, 0), a3, voffA);
            PG8_BAR; PG8_WAIT_L(0); PG8_MMA(1, 0, At, B0); PG8_BAR; PG8_SCHED;
            PG8_STAGE(PG8_SB(1, 1), b3 + hstep, voffB);
            PG8_WAIT_V(6); PG8_BAR; PG8_MMA(1, 1, At, B1); PG8_BAR;
            }
        }
        if constexpr (Epi::F8) asm volatile("s_nop 15\n\ts_nop 15" ::: "memory");
        if constexpr (ALIGN_EPI) { if (wr == 0) PG8_BAR; }
        if constexpr (!Epi::AFTER_DRAIN) { E(acc, cur, wr, wc, fr, fq); S.done(cur); }
        if (!has_next) break;
#pragma unroll
        for (int a = 0; a < 2; ++a)
#pragma unroll
            for (int b = 0; b < 2; ++b)
#pragma unroll
                for (int m = 0; m < 4; ++m)
#pragma unroll
                    for (int n = 0; n < 2; ++n) acc[a][b][m][n] = (f32x4){0.f, 0.f, 0.f, 0.f};
        cur = nxt; cA = nA; cB = nB; ++ui;
        if constexpr (ALIGN_EPI) { if (wr == 1) PG8_BAR; }
    }
    PG8_WAIT_V(0);
    if constexpr (!ALIGN_EPI) { if (wr == 0) PG8_BAR; }
    PG8_BAR;
    if constexpr (Epi::AFTER_DRAIN) { E.fused(acc, cur, wr, wc, fr, fq, lds, wid, lane); S.done(cur); }
#undef PG8_SA
#undef PG8_SB
#undef PG8_STAGE
#undef PG8_LDA
#undef PG8_LDB
#undef PG8_MMA
#undef PG8_WAIT_V
#undef PG8_WAIT_L
#undef PG8_BAR
#undef PG8_SCHED
}
#endif
}

namespace pg8 {
struct EpiStoreBf16 {
    static constexpr bool PERM = true, AFTER_DRAIN = false, F8 = false;
    bf16_t* O; int ldc; int ntn;
    __device__ __forceinline__ void operator()(const f32x4 (&acc)[2][2][4][2], const Unit& u, int wr, int wc, int fr, int fq) const {
        const int row0 = u.pm * BM + wr * 64 + fr, col0 = (u.pn % ntn) * BM + wc * 32 + 8 * fq;
#pragma unroll
        for (int ai = 0; ai < 2; ++ai)
#pragma unroll
            for (int m = 0; m < 4; ++m) { bf16_t* rowp = O + (size_t)(row0 + ai * HALF + m * 16) * ldc + col0;
#pragma unroll
                for (int bj = 0; bj < 2; ++bj) { const f32x4 v0 = acc[ai][bj][m][0], v1 = acc[ai][bj][m][1];
                    u32x4 w; w.x = pk2(v0[0], v0[1]); w.y = pk2(v0[2], v0[3]); w.z = pk2(v1[0], v1[1]); w.w = pk2(v1[2], v1[3]);
                    *(u32x4*)(rowp + bj * HALF) = w; } }
    }
};
struct EpiSwiglu {
    static constexpr bool PERM = true, AFTER_DRAIN = false, F8 = false;
    bf16_t* O; int ldc; int ntn;
    __device__ __forceinline__ void operator()(const f32x4 (&acc)[2][2][4][2], const Unit& u, int wr, int wc, int fr, int fq) const {
        const int row0 = u.pm * BM + wr * 64 + fr, col0 = (u.pn % ntn) * HALF + wc * 32 + 8 * fq;
#pragma unroll
        for (int ai = 0; ai < 2; ++ai)
#pragma unroll
            for (int m = 0; m < 4; ++m) { bf16_t* rowp = O + (size_t)(row0 + ai * HALF + m * 16) * ldc + col0;
                float hv[8];
#pragma unroll
                for (int n = 0; n < 2; ++n)
#pragma unroll
                    for (int q = 0; q < 4; ++q) { const float g = acc[ai][0][m][n][q], up = acc[ai][1][m][n][q]; hv[n * 4 + q] = silu_f(g) * up; }
                u32x4 w; w.x = pk2(hv[0], hv[1]); w.y = pk2(hv[2], hv[3]); w.z = pk2(hv[4], hv[5]); w.w = pk2(hv[6], hv[7]);
                *(u32x4*)rowp = w; }
    }
};
struct EpiStoreBf16S {
    static constexpr bool PERM = true, AFTER_DRAIN = false, F8 = true;
    bf16_t* O; int ldc; int ntn; float scl;
    __device__ __forceinline__ void operator()(const f32x4 (&acc)[2][2][4][2], const Unit& u, int wr, int wc, int fr, int fq) const {
        const int row0 = u.pm * BM + wr * 64 + fr, col0 = (u.pn % ntn) * BM + wc * 32 + 8 * fq;
#pragma unroll
        for (int ai = 0; ai < 2; ++ai)
#pragma unroll
            for (int m = 0; m < 4; ++m) { bf16_t* rowp = O + (size_t)(row0 + ai * HALF + m * 16) * ldc + col0;
#pragma unroll
                for (int bj = 0; bj < 2; ++bj) { const f32x4 v0 = acc[ai][bj][m][0] * scl, v1 = acc[ai][bj][m][1] * scl;
                    u32x4 w; w.x = pk2(v0[0], v0[1]); w.y = pk2(v0[2], v0[3]); w.z = pk2(v1[0], v1[1]); w.w = pk2(v1[2], v1[3]);
                    *(u32x4*)(rowp + bj * HALF) = w; } }
    }
};
struct EpiSwigluF8 {
    static constexpr bool PERM = true, AFTER_DRAIN = false, F8 = true;
    unsigned char* O; int ldc; int ntn; float scl;
    __device__ __forceinline__ void operator()(const f32x4 (&acc)[2][2][4][2], const Unit& u, int wr, int wc, int fr, int fq) const {
        const int row0 = u.pm * BM + wr * 64 + fr, col0 = (u.pn % ntn) * HALF + wc * 32 + 8 * fq;
#pragma unroll
        for (int ai = 0; ai < 2; ++ai)
#pragma unroll
            for (int m = 0; m < 4; ++m) { unsigned char* rowp = O + (size_t)(row0 + ai * HALF + m * 16) * ldc + col0;
                float hv[8];
#pragma unroll
                for (int n = 0; n < 2; ++n)
#pragma unroll
                    for (int q = 0; q < 4; ++q) { const float g = acc[ai][0][m][n][q] * scl, up = acc[ai][1][m][n][q] * (scl * F8_SM); hv[n * 4 + q] = silu_f(g) * up; }
                u32x2 w; w.x = pk4_f8(hv[0], hv[1], hv[2], hv[3]); w.y = pk4_f8(hv[4], hv[5], hv[6], hv[7]);
                *(u32x2*)rowp = w; }
    }
};
struct EpiResid {
    static constexpr bool PERM = false, AFTER_DRAIN = false, F8 = false;
    const float* Xin; float* Xout; const float* gate_lat; const float* gate_ctx;
    __device__ __forceinline__ void operator()(const f32x4 (&acc)[2][2][4][2], const Unit& u, int wr, int wc, int fr, int fq) const {
        const float* gp = (u.pm == 0) ? gate_ctx : gate_lat;
        const int row0 = u.pm * BM + wr * 64 + fr, col0 = u.pn * BM + wc * 32 + 4 * fq;
#pragma unroll
        for (int bj = 0; bj < 2; ++bj)
#pragma unroll
            for (int n = 0; n < 2; ++n) { const int col = col0 + bj * HALF + n * 16; const f32x4 gv = *(const f32x4*)(gp + col);
#pragma unroll
                for (int ai = 0; ai < 2; ++ai)
#pragma unroll
                    for (int m = 0; m < 4; ++m) { const size_t o = (size_t)(row0 + ai * HALF + m * 16) * D + col; *(f32x4*)(Xout + o) = *(const f32x4*)(Xin + o) + gv * acc[ai][bj][m][n]; } }
    }
};
struct EpiQkvRope {
    static constexpr bool PERM = true, AFTER_DRAIN = false, F8 = false;
    bf16_t* QR; bf16_t* KR; bf16_t* P; const float* tab; unsigned* kb;
    __device__ __forceinline__ void operator()(const f32x4 (&acc)[2][2][4][2], const Unit& u, int wr, int wc, int fr, int fq) const {
        const int row0 = u.pm * BM + wr * 64 + fr, lane = fq * 16 + fr;
        if (u.pn >= 8) {
            const int col0 = u.pn * BM + wc * 32 + 8 * fq;
#pragma unroll
            for (int ai = 0; ai < 2; ++ai)
#pragma unroll
                for (int m = 0; m < 4; ++m) { bf16_t* rowp = P + (size_t)(row0 + ai * HALF + m * 16) * DQKV + col0;
#pragma unroll
                    for (int bj = 0; bj < 2; ++bj) { const f32x4 v0 = acc[ai][bj][m][0], v1 = acc[ai][bj][m][1];
                        u32x4 w; w.x = pk2(v0[0], v0[1]); w.y = pk2(v0[2], v0[3]); w.z = pk2(v1[0], v1[1]); w.w = pk2(v1[2], v1[3]);
                        *(u32x4*)(rowp + bj * HALF) = w; } }
            return;
        }
        const bool isq = u.pn < 4; bf16_t* dst = isq ? QR : KR; const float scl = isq ? QSCALE : 1.0f;
        const int axis = wc & 1, i0 = 8 * (fq & 1); const float sgn = (fq & 2) ? 1.0f : -1.0f;
        float kmx[2] = {0.f, 0.f};
#pragma unroll
        for (int ai = 0; ai < 2; ++ai)
#pragma unroll
            for (int m = 0; m < 4; ++m) { const int row = row0 + ai * HALF + m * 16; const int pa = axis ? (row % GRID_W) : (row / GRID_W);
                const f32x4* tp = (const f32x4*)(tab + (size_t)(pa * 16 + i0) * 2); const f32x4 t0 = tp[0], t1 = tp[1], t2 = tp[2], t3 = tp[3];
                const float cs[8] = {t0[0], t0[2], t1[0], t1[2], t2[0], t2[2], t3[0], t3[2]}, sn[8] = {t0[1], t0[3], t1[1], t1[3], t2[1], t2[3], t3[1], t3[3]};
#pragma unroll
                for (int bj = 0; bj < 2; ++bj) { float o[8]; float ssq = 0.f;
#pragma unroll
                    for (int k = 0; k < 8; ++k) { const float own = acc[ai][bj][m][k >> 2][k & 3]; const float par = PARTNER32(own, lane); o[k] = (own * cs[k] + sgn * par * sn[k]) * scl; }
                    u32x4 w; w.x = pk2(o[0], o[1]); w.y = pk2(o[2], o[3]); w.z = pk2(o[4], o[5]); w.w = pk2(o[6], o[7]);
                    *(u32x4*)(dst + (size_t)(CTX + row) * D + (u.pn & 3) * BM + bj * HALF + wc * 32 + 8 * fq) = w;
                    if (!isq) {
#pragma unroll
                        for (int e = 0; e < 4; ++e) ssq += bflo(w[e]) * bflo(w[e]) + bfhi(w[e]) * bfhi(w[e]);
                        kmx[bj] = fmaxf(kmx[bj], ssq); } } }
        if (!isq) {
#pragma unroll
            for (int bj = 0; bj < 2; ++bj) { float v = kmx[bj];
#pragma unroll
                for (int o2 = 1; o2 < 16; o2 <<= 1) v = fmaxf(v, SHX(v, o2, lane));
                const int head = (u.pn & 3) * 2 + bj, map = wc >> 1, part = (wc & 1) * 4 + fq;
                if (fr == 0) atomicMax(kb + (head * 2 + map) * 8 + part, __builtin_bit_cast(unsigned, v)); }
        }
    }
};
struct MoeOrder {
    const int* tab; int ntn, G, c;
    __device__ __forceinline__ bool next(int i, Unit& u) const {
        const int ntr = tab[0]; const long L = (long)i * G + c; if (L >= (long)ntr * ntn) return false;
        const int rt = (int)(L / ntn), ct = (int)(L % ntn); u.pm = rt; u.pn = tab[16 + rt] * ntn + ct; return true;
    }
    __device__ __forceinline__ void a_ready(const Unit&) const {}
    __device__ __forceinline__ void done(const Unit&) const {}
};
}

#ifndef CPU_SIM
#define XB_TMO      128
#define XB_XCNT(j)  (256  + 64 * (j))
#define XB_XSUB(j)  (1280 + 64 * (j))
#define XB_XGEN(j)  (2304 + 64 * (j))
#define XB_TOP      3328
#define XB_TOPGEN   3392
#define XCD_BAR_WORDS 3456
#define XB_SPIN_CAP (1u << 18)
__device__ __forceinline__ unsigned xb_ld(unsigned* p)              { return __hip_atomic_load(p, __ATOMIC_RELAXED, __HIP_MEMORY_SCOPE_AGENT); }
__device__ __forceinline__ unsigned xb_add(unsigned* p, unsigned v) { return __hip_atomic_fetch_add(p, v, __ATOMIC_RELAXED, __HIP_MEMORY_SCOPE_AGENT); }
__device__ __forceinline__ unsigned xb_xcc_id() { return (unsigned)__builtin_amdgcn_s_getreg((3 << 11) | 20) & 0xFu; }
#define XB_SPIN(cond, bar) do { unsigned _sp = 0; while (cond) { __builtin_amdgcn_s_sleep(1); \
    if ((++_sp & 255u) == 0u) { if (xb_ld(&(bar)[XB_TMO])) break; if (_sp > XB_SPIN_CAP) { atomicAdd(&(bar)[XB_TMO], 1u); break; } } } } while (0)
struct XcdBarrier { unsigned* bar; unsigned x; volatile LAS unsigned* st; };
__device__ __forceinline__ XcdBarrier xcd_barrier_post(unsigned* bar, volatile LAS unsigned* st, int tid) {
    XcdBarrier b; b.bar = bar; b.x = xb_xcc_id(); b.st = st;
    if (tid == 0) (void)xb_add(&bar[XB_XCNT(b.x)], 1u);
    return b;
}
__device__ __forceinline__ void xcd_barrier_complete(unsigned* bar, unsigned x, unsigned& nloc, unsigned& nx) {
    const unsigned G = gridDim.x * gridDim.y * gridDim.z;
    unsigned sum, cnt, mine, sp = 0u;
    for (;;) {
        sum = 0u; cnt = 0u; mine = 0u;
#pragma unroll
        for (unsigned j = 0; j < 16; ++j) { const unsigned c = xb_ld(&bar[XB_XCNT(j)]); sum += c; cnt += (c > 0u) ? 1u : 0u; mine = (j == x) ? c : mine; }
        if (sum == G) break;
        __builtin_amdgcn_s_sleep(1);
        if ((++sp & 255u) == 0u) { if (xb_ld(&bar[XB_TMO])) break; if (sp > XB_SPIN_CAP) { atomicAdd(&bar[XB_TMO], 1u); break; } }
    }
    nloc = mine > 0u ? mine : 1u; nx = cnt > 0u ? cnt : 1u;
}
__device__ __forceinline__ void xcd_barrier(const XcdBarrier& b, int tid) {
    asm volatile("s_waitcnt vmcnt(0)" ::: "memory");
    __syncthreads();
    if (tid == 0) {
        unsigned* bar = b.bar;
        __builtin_amdgcn_s_waitcnt(0);
        unsigned nloc = b.st[0], nx = b.st[1];
        if (nloc == 0u) { xcd_barrier_complete(bar, b.x, nloc, nx); b.st[0] = nloc; b.st[1] = nx; }
        const unsigned old = xb_add(&bar[XB_XSUB(b.x)], 1u);
        const unsigned gen = old / nloc;
        if (old + 1u == (gen + 1u) * nloc) {
            __builtin_amdgcn_fence(__ATOMIC_RELEASE, "agent");
            asm volatile("s_waitcnt vmcnt(0)" ::: "memory");
            const unsigned og = xb_add(&bar[XB_TOP], 1u);
            const unsigned tg = og / nx;
            if (og + 1u == (tg + 1u) * nx) xb_add(&bar[XB_TOPGEN], 1u);
            else XB_SPIN(xb_ld(&bar[XB_TOPGEN]) == tg, bar);
            __builtin_amdgcn_fence(__ATOMIC_ACQUIRE, "agent");
            xb_add(&bar[XB_XGEN(b.x)], 1u);
            asm volatile("s_waitcnt vmcnt(0)" ::: "memory");
        } else {
            XB_SPIN(xb_ld(&bar[XB_XGEN(b.x)]) == gen, bar);
            __builtin_amdgcn_fence(__ATOMIC_ACQUIRE, "agent");
            asm volatile("s_waitcnt vmcnt(0)" ::: "memory");
        }
    }
    __syncthreads();
}
#endif

struct KArgs { const float* in[26]; float* out; unsigned char* ws; int ph_lo, ph_hi; int variant; };
#ifdef CPU_SIM
typedef const KArgs* KArgP;
#define TIDX(a) ((a).tid)
#define FRESH_TID(a) ((int)threadIdx.x)
#else
typedef const __attribute__((address_space(4))) KArgs* KArgP;
#define TIDX(a) ((a).tid)
#define FRESH_TID(a) ({ unsigned z_ = 0u; asm volatile("" : "+s"(z_)); (a).wv * 64 + (int)__builtin_amdgcn_mbcnt_hi(~0u, __builtin_amdgcn_mbcnt_lo(~0u, z_)); })
#endif
struct KCtx { KArgP p; int wv, tid, bx, G; LAS unsigned char* L; };
enum { I_X = 0, I_C, I_CTX, I_CCTX, I_MODW, I_MODB, I_HGLB, I_EVWIN, I_HGNG, I_SGLNG, I_SGLNB, I_SGW, I_SGB, I_EVWOUT, I_DAQKV, I_DALAM, I_DASUBG, I_DAWOUT,
       I_FFG, I_FFU, I_FFD, I_MOER, I_MOEG, I_MOEU, I_MOED, I_FING };

#define WSP(T_, off) ((T_*)(a.p->ws + (off)))

__device__ __forceinline__ void tr_item(const float* W, int N, int K, bf16_t* WT, int k0, int n0, int drow0, LAS float* scr, int lane) {
    float wv[64];
#pragma unroll
    for (int kk = 0; kk < 64; ++kk) wv[kk] = W[(size_t)(k0 + kk) * N + n0 + lane];
#pragma unroll
    for (int kk = 0; kk < 64; ++kk) scr[kk * 65 + lane] = wv[kk];
    WAVE_SYNC();
    const int c = lane & 7;
#pragma unroll
    for (int j = 0; j < 8; ++j) { const int n = (lane >> 3) + 8 * j; const LAS float* s = scr + (8 * c) * 65 + n;
        u32x4 o; o.x = pk2(s[0 * 65], s[1 * 65]); o.y = pk2(s[2 * 65], s[3 * 65]); o.z = pk2(s[4 * 65], s[5 * 65]); o.w = pk2(s[6 * 65], s[7 * 65]);
        *(u32x4*)(WT + (size_t)(drow0 + n) * K + k0 + 8 * c) = o; }
    WAVE_SYNC();
}
__device__ __forceinline__ void tr_item8(const float* W, int N, int K, unsigned char* WT, int k0, int n0, int drow0, LAS float* scr, int lane) {
    float wv[64];
#pragma unroll
    for (int kk = 0; kk < 64; ++kk) wv[kk] = W[(size_t)(k0 + kk) * N + n0 + lane];
#pragma unroll
    for (int kk = 0; kk < 64; ++kk) scr[kk * 65 + lane] = wv[kk];
    WAVE_SYNC();
    const int c = lane & 3;
#pragma unroll
    for (int j = 0; j < 4; ++j) { const int n = (lane >> 2) + 16 * j; const LAS float* s = scr + (16 * c) * 65 + n;
        u32x4 o; o.x = pk4_f8(s[0 * 65] * F8_SW, s[1 * 65] * F8_SW, s[2 * 65] * F8_SW, s[3 * 65] * F8_SW); o.y = pk4_f8(s[4 * 65] * F8_SW, s[5 * 65] * F8_SW, s[6 * 65] * F8_SW, s[7 * 65] * F8_SW);
        o.z = pk4_f8(s[8 * 65] * F8_SW, s[9 * 65] * F8_SW, s[10 * 65] * F8_SW, s[11 * 65] * F8_SW); o.w = pk4_f8(s[12 * 65] * F8_SW, s[13 * 65] * F8_SW, s[14 * 65] * F8_SW, s[15 * 65] * F8_SW);
        *(u32x4*)(WT + (size_t)(drow0 + n) * K + k0 + 16 * c) = o; }
    WAVE_SYNC();
}
template <int MODE, bool F8 = false>
__device__ __forceinline__ void tr_mat(const float* W, int K, int N, bf16_t* WT, LAS float* scr, int gw, int NGW, int lane, int& itbase) {
    const int nblk = N / 64, nitems = (K / 64) * nblk;
    for (int it = ((gw - itbase) % NGW + NGW) % NGW; it < nitems; it += NGW) {
        const int kb = it / nblk, nb = it % nblk, n0 = nb * 64;
        const int drow0 = MODE == 0 ? n0 : ((n0 >> 7) * 256 + (n0 & 127) + (MODE == 2 ? 128 : 0));
        if (F8) tr_item8(W, N, K, (unsigned char*)WT, kb * 64, n0, drow0, scr, lane); else tr_item(W, N, K, WT, kb * 64, n0, drow0, scr, lane);
    }
    itbase = (itbase + nitems) % NGW;
}
__device__ __forceinline__ void moe_weights(const KCtx& a, int j, LAS unsigned char* lds, int& itbase) {
    const int tid = TIDX(a), lane = tid & 63, wave = rfl(tid >> 6), gw = a.bx * NWAVES + wave, NGW = a.G * NWAVES;
    LAS float* scr = (LAS float*)(lds + wave * 16896);
    for (int e = 0; e < NEXP; ++e) {
        bf16_t* gu = (bf16_t*)(WSP(unsigned char, WS_MGU) + (size_t)e * 2 * EFF * D); bf16_t* dn = (bf16_t*)(WSP(unsigned char, WS_MDN) + (size_t)e * D * EFF);
        tr_mat<1, true>(a.p->in[I_MOEG] + (size_t)(j * NEXP + e) * D * EFF, D, EFF, gu, scr, gw, NGW, lane, itbase);
        tr_mat<2, true>(a.p->in[I_MOEU] + (size_t)(j * NEXP + e) * D * EFF, D, EFF, gu, scr, gw, NGW, lane, itbase);
        tr_mat<0, true>(a.p->in[I_MOED] + (size_t)(j * NEXP + e) * EFF * D, EFF, D, dn, scr, gw, NGW, lane, itbase);
    }
}
__device__ __forceinline__ void ph_prologue(const KCtx& a, LAS unsigned char* lds) {
    const int tid = TIDX(a), lane = tid & 63, wave = rfl(tid >> 6), gw = a.bx * NWAVES + wave, NGW = a.G * NWAVES;
    LAS float* sv = (LAS float*)lds;
    for (int i = tid; i < 2048; i += NTHR) sv[i] = silu_f(i < 1024 ? a.p->in[I_C][i] : a.p->in[I_CCTX][i - 1024]);
    __syncthreads();
    float* modv = WSP(float, WS_SMALL + SM_MODV);
    LAS float* part = (LAS float*)(lds + 8192);
    for (int it = a.bx; it < 4 * 96; it += a.G) {
        const int l = it / 96, n = (it % 96) * 64 + lane; const float* W = a.p->in[I_MODW] + (size_t)l * D * 6144 + (size_t)(wave * 128) * 6144 + n; float a0 = 0.f, a1 = 0.f;
#pragma unroll 16
        for (int k = 0; k < 128; ++k) { const float w = W[(size_t)k * 6144]; a0 += sv[wave * 128 + k] * w; a1 += sv[1024 + wave * 128 + k] * w; }
        part[(wave * 2 + 0) * 64 + lane] = a0; part[(wave * 2 + 1) * 64 + lane] = a1;
        __syncthreads();
        if (wave < 2) { float sacc = 0.f;
#pragma unroll
            for (int w = 0; w < 8; ++w) sacc += part[(w * 2 + wave) * 64 + lane];
            modv[(l * 2 + wave) * 6144 + n] = sacc + a.p->in[I_MODB][l * 6144 + n]; }
        __syncthreads();
    }
    __syncthreads();
    { const int gt0 = a.bx * NTHR + tid; if (gt0 < 256 * 16) { const int pos = gt0 >> 4, i = gt0 & 15; const float ang = (float)pos * expf(-(float)(2 * i) * (1.0f / 32.0f) * 9.210340371976184f);
        float* tb = WSP(float, WS_SMALL + SM_ROPE) + gt0 * 2; tb[0] = cosf(ang); tb[1] = sinf(ang); } }
    if (a.bx == 0 && wave < 2) {
        const float* lm = a.p->in[I_DALAM] + wave * 256; const float s1 = wave_sum(lm[lane] * lm[64 + lane], lane), s2 = wave_sum(lm[128 + lane] * lm[192 + lane], lane);
        const float lam_init = 0.8f - 0.6f * expf(-0.3f * (float)(2 * wave + 1));
        if (lane == 0) WSP(float, WS_SMALL + SM_LAMF)[wave] = expf(s1) - expf(s2) + lam_init;
    }
    { const int gt = a.bx * NTHR + tid, NGT = a.G * NTHR;
      bf16_t* sgw = WSP(bf16_t, WS_SGW);
      for (int i = gt; i < 2 * 4 * 128 * 128; i += NGT) sgw[i] = (bf16_t)f2bf(a.p->in[I_SGW][i]); }
    LAS float* scr = (LAS float*)(lds + wave * 16896);
    int itbase = 0;
    for (int j = 0; j < 2; ++j) {
        tr_mat<0>(a.p->in[I_EVWIN] + (size_t)j * D * EVEN_IN, D, EVEN_IN, WSP(bf16_t, WS_WIN + j * SZ_WIN), scr, gw, NGW, lane, itbase);
        tr_mat<0>(a.p->in[I_EVWOUT] + (size_t)j * D * D, D, D, WSP(bf16_t, WS_WEO + j * SZ_WSQ), scr, gw, NGW, lane, itbase);
        tr_mat<1>(a.p->in[I_FFG] + (size_t)j * D * DFF, D, DFF, WSP(bf16_t, WS_WGU + j * SZ_WGU), scr, gw, NGW, lane, itbase);
        tr_mat<2>(a.p->in[I_FFU] + (size_t)j * D * DFF, D, DFF, WSP(bf16_t, WS_WGU + j * SZ_WGU), scr, gw, NGW, lane, itbase);
        tr_mat<0>(a.p->in[I_FFD] + (size_t)j * DFF * D, DFF, D, WSP(bf16_t, WS_WDN + j * SZ_WDN), scr, gw, NGW, lane, itbase);
        tr_mat<0>(a.p->in[I_DAQKV] + (size_t)j * D * DQKV, D, DQKV, WSP(bf16_t, WS_WQKV + j * SZ_WQKV), scr, gw, NGW, lane, itbase);
        tr_mat<0>(a.p->in[I_DAWOUT] + (size_t)j * D * D, D, D, WSP(bf16_t, WS_WAO + j * SZ_WSQ), scr, gw, NGW, lane, itbase);
    }
    moe_weights(a, 0, lds, itbase);
}

template <bool COMBINE, bool ROUTER, bool FINAL, bool FROMIN = false>
__device__ __forceinline__ void ph_rowpass(const KCtx& a, int layer, int which) {
    const int tid = TIDX(a), lane = tid & 63, wave = rfl(tid >> 6), gw = a.bx * NWAVES + wave, NGW = a.G * NWAVES;
    const float* X = (COMBINE || which == 1) ? WSP(float, WS_X1) : WSP(float, WS_X); float* XW = WSP(float, WS_X);
    const float* XC = a.p->in[I_CTX]; const float* XL = a.p->in[I_X] - (size_t)CTX * D;
#define ROWP(r) (FROMIN ? (((r) < CTX ? XC : XL) + (size_t)(r) * D) : (X + (size_t)(r) * D))
    bf16_t* H = WSP(bf16_t, WS_H); const float* modv = WSP(float, WS_SMALL + SM_MODV);
    const int* tok_pos = WSP(int, WS_TOK + (size_t)T * 16); const float* tok_w = WSP(float, WS_TOK + (size_t)T * 8);
    f32x4 vn[4];
    { const int r0 = gw < T ? gw : 0;
#pragma unroll
      for (int j = 0; j < 4; ++j) vn[j] = *(const f32x4*)(ROWP(r0) + 4 * lane + 256 * j); }
    int tp0 = 0, tp1 = 0, tw0 = 0, tw1 = 0; u32x2 yn0[4], yn1[4];
    if (COMBINE) {
        const int rr = gw + lane * NGW;
        if (rr < T) { tp0 = tok_pos[rr * 2]; tp1 = tok_pos[rr * 2 + 1]; tw0 = __builtin_bit_cast(int, tok_w[rr * 2]); tw1 = __builtin_bit_cast(int, tok_w[rr * 2 + 1]); }
        const bf16_t* y0 = WSP(bf16_t, WS_Y) + (size_t)SHI(tp0, 0, lane) * D; const bf16_t* y1 = WSP(bf16_t, WS_Y) + (size_t)SHI(tp1, 0, lane) * D;
#pragma unroll
        for (int j = 0; j < 4; ++j) { yn0[j] = *(const u32x2*)(y0 + 4 * lane + 256 * j); yn1[j] = *(const u32x2*)(y1 + 4 * lane + 256 * j); }
    }
    int it = 0;
    for (int row = gw; row < T; row += NGW, ++it) {
        const int s = row < CTX ? 1 : 0;
        f32x4 v[4];
#pragma unroll
        for (int j = 0; j < 4; ++j) v[j] = vn[j];
        { const int rn = row + NGW < T ? row + NGW : row;
#pragma unroll
          for (int j = 0; j < 4; ++j) vn[j] = *(const f32x4*)(ROWP(rn) + 4 * lane + 256 * j); }
        u32x2 yc0[4], yc1[4]; float w0 = 0.f, w1 = 0.f;
        if (COMBINE) {
#pragma unroll
            for (int j = 0; j < 4; ++j) { yc0[j] = yn0[j]; yc1[j] = yn1[j]; }
            w0 = __builtin_bit_cast(float, SHI(tw0, it, lane)); w1 = __builtin_bit_cast(float, SHI(tw1, it, lane));
            const bf16_t* y0 = WSP(bf16_t, WS_Y) + (size_t)SHI(tp0, it + 1, lane) * D; const bf16_t* y1 = WSP(bf16_t, WS_Y) + (size_t)SHI(tp1, it + 1, lane) * D;
#pragma unroll
            for (int j = 0; j < 4; ++j) { yn0[j] = *(const u32x2*)(y0 + 4 * lane + 256 * j); yn1[j] = *(const u32x2*)(y1 + 4 * lane + 256 * j); }
        }
        if (FINAL && row < CTX) continue;
        if (COMBINE) {
            const int lp = FINAL ? 3 : layer - 1; const float* g2 = modv + ((lp * 2 + s) * 6 + 5) * 1024;
#pragma unroll
            for (int j = 0; j < 4; ++j) { const int col = 4 * lane + 256 * j; const u32x2 r0 = yc0[j], r1 = yc1[j]; const f32x4 g = *(const f32x4*)(g2 + col);
                v[j][0] += g[0] * (w0 * bflo(r0.x) + w1 * bflo(r1.x)); v[j][1] += g[1] * (w0 * bfhi(r0.x) + w1 * bfhi(r1.x));
                v[j][2] += g[2] * (w0 * bflo(r0.y) + w1 * bflo(r1.y)); v[j][3] += g[3] * (w0 * bfhi(r0.y) + w1 * bfhi(r1.y));
                if (!FINAL) *(f32x4*)(XW + (size_t)row * D + col) = v[j]; }
        }
        float ss = 0.f;
#pragma unroll
        for (int j = 0; j < 4; ++j) ss += (v[j][0] * v[j][0] + v[j][1] * v[j][1]) + (v[j][2] * v[j][2] + v[j][3] * v[j][3]);
        ss = wave_sum(ss, lane); const float r = 1.0f / sqrtf(ss * (1.0f / D) + 1e-6f);
        if (FINAL) {
            float* o = a.p->out + (size_t)(row - CTX) * D;
#pragma unroll
            for (int j = 0; j < 4; ++j) { const int col = 4 * lane + 256 * j; const f32x4 g = *(const f32x4*)(a.p->in[I_FING] + col); *(f32x4*)(o + col) = v[j] * r * g; }
            continue;
        }
        const float* mv = modv + ((layer * 2 + s) * 6 + which * 3) * 1024;
        float lg[8];
#pragma unroll
        for (int e = 0; e < 8; ++e) lg[e] = 0.f;
#pragma unroll
        for (int j = 0; j < 4; ++j) { const int col = 4 * lane + 256 * j; const f32x4 sh = *(const f32x4*)(mv + col), sc = *(const f32x4*)(mv + 1024 + col);
            const f32x4 y = v[j] * r * (sc + 1.0f) + sh;
            if (ROUTER) { *(unsigned*)((unsigned char*)H + (size_t)row * D + col) = pk4_f8(y[0] * F8_SH, y[1] * F8_SH, y[2] * F8_SH, y[3] * F8_SH); }
            else { u32x2 w; w.x = pk2(y[0], y[1]); w.y = pk2(y[2], y[3]); *(u32x2*)(H + (size_t)row * D + col) = w; }
            if (ROUTER) { const float* wr = a.p->in[I_MOER] + (size_t)(layer >> 1) * D * NEXP + (size_t)col * NEXP;
#pragma unroll
                for (int q = 0; q < 4; ++q) { const f32x4 wa = *(const f32x4*)(wr + q * 8), wb = *(const f32x4*)(wr + q * 8 + 4);
                    lg[0] += y[q] * wa[0]; lg[1] += y[q] * wa[1]; lg[2] += y[q] * wa[2]; lg[3] += y[q] * wa[3]; lg[4] += y[q] * wb[0]; lg[5] += y[q] * wb[1]; lg[6] += y[q] * wb[2]; lg[7] += y[q] * wb[3]; } }
        }
        if (ROUTER) {
            { float r4[4], r2[2], r1; const bool u5 = (lane & 32) != 0, u4 = (lane & 16) != 0, u3 = (lane & 8) != 0;
#pragma unroll
              for (int q = 0; q < 4; ++q) { const float mine = u5 ? lg[4 + q] : lg[q], send = u5 ? lg[q] : lg[4 + q]; r4[q] = mine + SHX(send, 32, lane); }
#pragma unroll
              for (int q = 0; q < 2; ++q) { const float mine = u4 ? r4[2 + q] : r4[q], send = u4 ? r4[q] : r4[2 + q]; r2[q] = mine + SHX(send, 16, lane); }
              { const float mine = u3 ? r2[1] : r2[0], send = u3 ? r2[0] : r2[1]; r1 = mine + SHX(send, 8, lane); }
              r1 += SHX(r1, 4, lane); r1 += SHX(r1, 2, lane); r1 += SHX(r1, 1, lane);
#pragma unroll
              for (int e = 0; e < 8; ++e) lg[e] = SHC(r1, 32 * (e >> 2) + 16 * ((e >> 1) & 1) + 8 * (e & 1)); }
            int e0 = 0; float b0 = lg[0];
#pragma unroll
            for (int e = 1; e < 8; ++e) if (lg[e] > b0) { b0 = lg[e]; e0 = e; }
            int e1 = -1; float b1 = -3.0e38f;
#pragma unroll
            for (int e = 0; e < 8; ++e) if (e != e0 && lg[e] > b1) { b1 = lg[e]; e1 = e; }
            if (lane == 0) { const float w0 = 1.0f / (1.0f + expf(b1 - b0));
                int* te = WSP(int, WS_TOK); float* tw = WSP(float, WS_TOK + (size_t)T * 8);
                te[row * 2] = e0; te[row * 2 + 1] = e1; tw[row * 2] = w0; tw[row * 2 + 1] = 1.0f - w0;
                unsigned* cnt = WSP(unsigned, WS_CTL) + CW_MOECNT + (layer >> 1) * 64;
                atomicAdd(cnt + e0, 1u); atomicAdd(cnt + e1, 1u); }
        }
    }
}

#undef ROWP
template <int MODE>
__device__ __forceinline__ void ctx_gemm(const KCtx& a, const bf16_t* A, const bf16_t* Bt, int K, int NC, bf16_t* O, int ldc, const float* Xin, float* Xout, const float* gate, LAS unsigned char* lds) {
    const int tid = TIDX(a), lane = tid & 63, wave = rfl(tid >> 6), fr = lane & 15, fq = lane >> 4, slot = wave >> 2, ks = wave & 3;
    const int nitems = 16 * (NC / 32), nb = K / 128;
    LAS f32x4* red = (LAS f32x4*)lds;
    __syncthreads();
    for (int base = a.bx * 2; base < nitems; base += a.G * 2) {
        const int it = base + slot; const bool valid = it < nitems; const int itc = valid ? it : 0;
        const int r0 = (itc & 15) * 16, c0 = (itc >> 4) * 32;
        const int wslot = 8 * (fr >> 2) + (fr & 3);
        const bf16_t* xp = A + (size_t)(r0 + fr) * K + 8 * fq;
        const bf16_t* wp = Bt + (size_t)(c0 + wslot) * K + 8 * fq;
        f32x4 acc[2];
        acc[0] = (f32x4){0.f, 0.f, 0.f, 0.f}; acc[1] = acc[0];
        bf16x8 xa[4], wa[4][2], xb[4], wb[4][2];
#define CTX_LOAD(xf, wf, kk) do { _Pragma("unroll") for (int s = 0; s < 4; ++s) { xf[s] = *(const bf16x8*)(xp + (kk) + 32 * s); \
            wf[s][0] = *(const bf16x8*)(wp + (kk) + 32 * s); wf[s][1] = *(const bf16x8*)(wp + (size_t)4 * K + (kk) + 32 * s); } } while (0)
#define CTX_MMA(xf, wf) do { _Pragma("unroll") for (int s = 0; s < 4; ++s) { acc[0] = mfma16(wf[s][0], xf[s], acc[0]); acc[1] = mfma16(wf[s][1], xf[s], acc[1]); } } while (0)
        if (ks < nb) CTX_LOAD(xa, wa, ks * 128);
        for (int b = ks; b < nb; b += 8) {
            if (b + 4 < nb) CTX_LOAD(xb, wb, (b + 4) * 128);
            CTX_MMA(xa, wa);
            if (b + 8 < nb) CTX_LOAD(xa, wa, (b + 8) * 128);
            if (b + 4 < nb) CTX_MMA(xb, wb);
        }
#undef CTX_LOAD
#undef CTX_MMA
        if (ks != 0) { red[((slot * 4 + ks) * 2 + 0) * 64 + lane] = acc[0]; red[((slot * 4 + ks) * 2 + 1) * 64 + lane] = acc[1]; }
        __syncthreads();
        if (ks == 0 && valid) {
#pragma unroll
            for (int k2 = 1; k2 < 4; ++k2) { acc[0] = acc[0] + red[((slot * 4 + k2) * 2 + 0) * 64 + lane]; acc[1] = acc[1] + red[((slot * 4 + k2) * 2 + 1) * 64 + lane]; }
            const int row = r0 + fr, col = c0 + 8 * fq;
            if (MODE == 0) { u32x4 w; w.x = pk2(acc[0][0], acc[0][1]); w.y = pk2(acc[0][2], acc[0][3]); w.z = pk2(acc[1][0], acc[1][1]); w.w = pk2(acc[1][2], acc[1][3]); *(u32x4*)(O + (size_t)row * ldc + col) = w; }
            else if (MODE == 3) {
                const float sc = col < 1024 ? QSCALE : 1.0f;
                u32x4 w; w.x = pk2(acc[0][0] * sc, acc[0][1] * sc); w.y = pk2(acc[0][2] * sc, acc[0][3] * sc); w.z = pk2(acc[1][0] * sc, acc[1][1] * sc); w.w = pk2(acc[1][2] * sc, acc[1][3] * sc);
                if (col < 1024) *(u32x4*)((bf16_t*)Xout + (size_t)row * D + col) = w;
                else if (col < 2048) { *(u32x4*)((bf16_t*)gate + (size_t)row * D + col - 1024) = w; float ssq = 0.f;
#pragma unroll
                    for (int e = 0; e < 4; ++e) ssq += bflo(w[e]) * bflo(w[e]) + bfhi(w[e]) * bfhi(w[e]);
                    const int cc = col - 1024; atomicMax((unsigned*)Xin + ((cc >> 7) * 2 + ((cc >> 6) & 1)) * 8 + ((cc & 63) >> 3), __builtin_bit_cast(unsigned, ssq)); }
                else *(u32x4*)(O + (size_t)row * ldc + col) = w;
            }
            else { const size_t o = (size_t)row * D + col;
                *(f32x4*)(Xout + o) = *(const f32x4*)(Xin + o) + *(const f32x4*)(gate + col) * acc[0]; *(f32x4*)(Xout + o + 4) = *(const f32x4*)(Xin + o + 4) + *(const f32x4*)(gate + col + 4) * acc[1]; }
        }
        __syncthreads();
    }
}

__device__ __forceinline__ bf16x8 trfrag(const LAS unsigned char* base, int pitchB, int k0, int c0, int lane) {
    const int g = lane >> 4, q = (lane & 15) >> 2, p = lane & 3;
    const LAS unsigned char* a0 = base + (k0 + 8 * g + q) * pitchB + (c0 + 4 * p) * 2;
    const s16x4 lo = ds_tr16(a0), hi = ds_tr16(a0 + 4 * pitchB);
    return (bf16x8){lo[0], lo[1], lo[2], lo[3], hi[0], hi[1], hi[2], hi[3]};
}
__device__ __forceinline__ bf16x8 rowfrag(const LAS unsigned char* base, int pitchB, int r0, int k0, int lane) {
    return *(const LAS bf16x8*)(base + (r0 + (lane & 15)) * pitchB + (k0 + 8 * (lane >> 4)) * 2);
}

constexpr int HG_CUM = 0, HG_KT = 32768, HG_VV = 50176, HG_QS = 67584, HG_QT = 84992, HG_SS = 102400, HG_PT = 137216, HG_LBV = 139264, HP = 272  ;
constexpr int P_EVQ = 0, P_EVFF = 512, P_EVI = 1536, P_EVG = 2048, P_EVU = 2560, P_EVV = 3072;

__device__ __forceinline__ void hg_gates_from(const KCtx& a, int j, int h, int dir, const u32x4 (&raw)[2], LAS unsigned char* lds) {
    const int tid = TIDX(a);
    LAS float* lbv = (LAS float*)(lds + HG_LBV); LAS float* CUM = (LAS float*)(lds + HG_CUM);
    if (tid < 128) { const float* lb = a.p->in[I_HGLB] + (size_t)dir * 2 * 512 + h * 128 + tid; lbv[tid] = (j == 0) ? 0.f : 1.0f / (1.0f + expf(lb[0] - lb[512])); }
    __syncthreads();
#pragma unroll
    for (int i = 0; i < 2; ++i) { const int p = tid + NTHR * i, row = p >> 4, c8 = (p & 15) * 8;
        *(LAS u32x4*)(lds + HG_KT + row * HP + c8 * 2) = raw[i];
#pragma unroll
        for (int e = 0; e < 8; ++e) { const unsigned w = raw[i][e >> 1]; const float f = (e & 1) ? bfhi(w) : bflo(w); const float lb = lbv[c8 + e];
            float lf = __logf(lb + (1.0f - lb) * sigm_f(f)); lf = fmaxf(lf, -30.0f); CUM[row * 128 + c8 + e] = lf; } }
}
__device__ __forceinline__ void hg_load_gates(const KCtx& a, int j, int c, int h, int dir, LAS unsigned char* lds) {
    const int tid = TIDX(a); const bf16_t* proj = WSP(bf16_t, WS_PROJ); u32x4 raw[2];
#pragma unroll
    for (int i = 0; i < 2; ++i) { const int p = tid + NTHR * i, row = p >> 4, c8 = (p & 15) * 8; raw[i] = *(const u32x4*)(proj + (size_t)(c * HCH + row) * EVEN_IN + P_EVFF + dir * 512 + h * 128 + c8); }
    hg_gates_from(a, j, h, dir, raw, lds);
}
__device__ __forceinline__ float hg_cumsum(const KCtx& a, int dir, LAS unsigned char* lds) {
    const int tid = TIDX(a), ch = tid & 127, part = tid >> 7;
    LAS float* CUM = (LAS float*)(lds + HG_CUM); LAS float* PT = (LAS float*)(lds + HG_PT);
    float run = 0.f;
    for (int i = 0; i < 16; ++i) { const int r = part * 16 + i, t = dir ? 63 - r : r; run += CUM[t * 128 + ch]; CUM[t * 128 + ch] = run; }
    PT[part * 128 + ch] = run;
    __syncthreads();
    float off = 0.f, tot = 0.f;
#pragma unroll
    for (int p = 0; p < 4; ++p) { const float v = PT[p * 128 + ch]; if (p < part) off += v; tot += v; }
    for (int i = 0; i < 16; ++i) { const int r = part * 16 + i, t = dir ? 63 - r : r; CUM[t * 128 + ch] += off; }
    return tot;
}
__device__ __forceinline__ void hg_unit_a(const KCtx& a, int j, int unit, LAS unsigned char* lds) {
    const int tid = TIDX(a), lane = tid & 63, wave = rfl(tid >> 6);
    const int dir = unit & 1, h = (unit >> 1) & 3, c = unit >> 3;
    __syncthreads();
    hg_load_gates(a, j, c, h, dir, lds);
    { const bf16_t* proj = WSP(bf16_t, WS_PROJ);
#pragma unroll
      for (int i = 0; i < 2; ++i) { const int p = tid + NTHR * i, row = p >> 4, c8 = (p & 15) * 8;
          *(LAS u32x4*)(lds + HG_VV + row * HP + c8 * 2) = *(const u32x4*)(proj + (size_t)(c * HCH + row) * EVEN_IN + P_EVI + h * 128 + c8); } }
    __syncthreads();
    const float tot = hg_cumsum(a, dir, lds);
    { const int ch = tid & 127, part = tid >> 7; LAS float* CUM = (LAS float*)(lds + HG_CUM); const float lb = ((LAS float*)(lds + HG_LBV))[ch];
      for (int i = 0; i < 16; ++i) { const int r = part * 16 + i, t = dir ? 63 - r : r; LAS bf16_t* kp = (LAS bf16_t*)(lds + HG_KT + t * HP) + ch;
          const float f = bf2f(*kp), kd = (1.0f - lb) * sigm_f(-f); *kp = (bf16_t)f2bf(kd * __expf(tot - CUM[t * 128 + ch])); }
      if (part == 0) WSP(float, WS_HGD)[(size_t)unit * 128 + ch] = __expf(tot); }
    __syncthreads();
    f32x4 acc[8];
#pragma unroll
    for (int i = 0; i < 8; ++i) acc[i] = (f32x4){0.f, 0.f, 0.f, 0.f};
#pragma unroll
    for (int ks = 0; ks < 2; ++ks) { const bf16x8 af = trfrag(lds + HG_KT, HP, 32 * ks, 16 * wave, lane);
#pragma unroll
        for (int vt = 0; vt < 8; ++vt) { const bf16x8 bf = trfrag(lds + HG_VV, HP, 32 * ks, 16 * vt, lane); acc[vt] = mfma16(af, bf, acc[vt]); } }
    bf16_t* U = WSP(bf16_t, WS_HGU) + (size_t)unit * 16384;
#pragma unroll
    for (int vt = 0; vt < 8; ++vt)
#pragma unroll
        for (int r = 0; r < 4; ++r) U[(16 * wave + 4 * (lane >> 4) + r) * 128 + 16 * vt + (lane & 15)] = (bf16_t)f2bf(acc[vt][r]);
}
__device__ __forceinline__ int hg_seq(int dir, int i) { return dir == 0 ? i : (i < NCC ? NCC - 1 - i : NCH - 1 - (i - NCC)); }
__device__ __forceinline__ void ph_hg_scan(const KCtx& a) {
    const unsigned* U = WSP(unsigned, WS_HGU); unsigned* Sst = WSP(unsigned, WS_HGS); const float* Dd = WSP(float, WS_HGD);
    for (int e = a.bx * NTHR + TIDX(a); e < 8 * 8192; e += a.G * NTHR) {
        const int v2 = e & 63, k = (e >> 6) & 127, hd = e >> 13, h = hd >> 1, dir = hd & 1;
        float s0 = 0.f, s1 = 0.f;
        constexpr int SCB = (NCH % 26 == 0) ? 26 : ((NCH % 4 == 0) ? 4 : 1);
        for (int i = 0; i < NCH; i += SCB) {
            unsigned u[SCB]; float d[SCB];
#pragma unroll
            for (int q = 0; q < SCB; ++q) { const int unit = (hg_seq(dir, i + q) * 4 + h) * 2 + dir; u[q] = U[(size_t)unit * 8192 + k * 64 + v2]; d[q] = Dd[(size_t)unit * 128 + k]; }
#pragma unroll
            for (int q = 0; q < SCB; ++q) { const int unit = (hg_seq(dir, i + q) * 4 + h) * 2 + dir; Sst[(size_t)unit * 8192 + k * 64 + v2] = pk2(s0, s1); s0 = d[q] * s0 + bflo(u[q]); s1 = d[q] * s1 + bfhi(u[q]); }
        }
    }
}
__device__ __forceinline__ void hg_unit_c(const KCtx& a, int j, int c, int h, LAS unsigned char* lds) {
    const int tid = TIDX(a), lane = tid & 63, wave = rfl(tid >> 6);
    const bf16_t* proj = WSP(bf16_t, WS_PROJ);
    u32x4 rq[2], rv[2], fg0[2], fg1[2], gr[2]; u32x2 s0[8], s1[8];
#pragma unroll
    for (int i = 0; i < 2; ++i) { const int p = tid + NTHR * i, row = p >> 4, c8 = (p & 15) * 8; const bf16_t* src = proj + (size_t)(c * HCH + row) * EVEN_IN + h * 128 + c8;
        rq[i] = *(const u32x4*)(src + P_EVQ); rv[i] = *(const u32x4*)(src + P_EVI); fg0[i] = *(const u32x4*)(src + P_EVFF); fg1[i] = *(const u32x4*)(src + P_EVFF + 512); }
    { const bf16_t* Sg = WSP(bf16_t, WS_HGS) + (size_t)((c * 4 + h) * 2) * 16384;
#pragma unroll
      for (int i = 0; i < 8; ++i) { const int p = tid + NTHR * i, k = p >> 5, v4 = (p & 31) * 4; s0[i] = *(const u32x2*)(Sg + k * 128 + v4); s1[i] = *(const u32x2*)(Sg + 16384 + k * 128 + v4); } }
    { const int t = tid >> 3, v0 = (tid & 7) * 16; const bf16_t* gsrc = proj + (size_t)(c * HCH + t) * EVEN_IN + P_EVG + h * 128 + v0; gr[0] = *(const u32x4*)gsrc; gr[1] = *(const u32x4*)(gsrc + 8); }
    __syncthreads();
#pragma unroll
    for (int i = 0; i < 2; ++i) { const int p = tid + NTHR * i, row = p >> 4, c8 = (p & 15) * 8;
        u32x4 sq;
#pragma unroll
        for (int e = 0; e < 4; ++e) sq[e] = pk2(silu_f(bflo(rq[i][e])), silu_f(bfhi(rq[i][e])));
        *(LAS u32x4*)(lds + HG_QS + row * HP + c8 * 2) = sq;
        *(LAS u32x4*)(lds + HG_VV + row * HP + c8 * 2) = rv[i]; }
    const int rt = wave >> 1;
    f32x4 acc[4];
#pragma unroll
    for (int i = 0; i < 4; ++i) acc[i] = (f32x4){0.f, 0.f, 0.f, 0.f};
#pragma unroll
    for (int dir = 0; dir < 2; ++dir) {
        __syncthreads();
        hg_gates_from(a, j, h, dir, dir ? fg1 : fg0, lds);
        __syncthreads();
        (void)hg_cumsum(a, dir, lds);
        __syncthreads();
        const int tp = dir ? 31 : 32;
        LAS float* CUM = (LAS float*)(lds + HG_CUM);
        { const int ch = tid & 127, part = tid >> 7; const float lb = ((LAS float*)(lds + HG_LBV))[ch]; const float cp = CUM[tp * 128 + ch];
          for (int i = 0; i < 16; ++i) { const int r = part * 16 + i, t = dir ? 63 - r : r; const float cum = CUM[t * 128 + ch];
              LAS bf16_t* kp = (LAS bf16_t*)(lds + HG_KT + t * HP) + ch; const float f = bf2f(*kp), kd = (1.0f - lb) * sigm_f(-f);
              *kp = (bf16_t)f2bf(kd * __expf(fminf(cp - cum, 80.f)));
              const float qs = bf2f(*((LAS bf16_t*)(lds + HG_QS + t * HP) + ch));
              *((LAS bf16_t*)(lds + HG_QT + t * HP) + ch) = (bf16_t)f2bf(qs * __expf(fminf(cum - cp, 80.f))); } }
#pragma unroll
        for (int i = 0; i < 8; ++i) { const int p = tid + NTHR * i, k = p >> 5, v4 = (p & 31) * 4; const u32x2 s = dir ? s1[i] : s0[i]; const float e = __expf(CUM[tp * 128 + k]);
            u32x2 w; w.x = pk2(bflo(s.x) * e, bfhi(s.x) * e); w.y = pk2(bflo(s.y) * e, bfhi(s.y) * e); *(LAS u32x2*)(lds + HG_SS + k * HP + v4 * 2) = w; }
        __syncthreads();
#pragma unroll
        for (int ii = 0; ii < 2; ++ii) { const int st = 2 * (wave & 1) + ii; f32x4 pa = (f32x4){0.f, 0.f, 0.f, 0.f};
#pragma unroll
            for (int ks = 0; ks < 4; ++ks) pa = mfma16(rowfrag(lds + HG_QT, HP, 16 * rt, 32 * ks, lane), rowfrag(lds + HG_KT, HP, 16 * st, 32 * ks, lane), pa);
            const int s = 16 * st + (lane & 15);
#pragma unroll
            for (int r = 0; r < 4; ++r) { const int t = 16 * rt + 4 * (lane >> 4) + r; const bool keep = dir ? (s >= t) : (s <= t);
                *((LAS bf16_t*)(lds + HG_CUM + t * 144) + s) = (bf16_t)f2bf(keep ? pa[r] : 0.f); } }
        __syncthreads();
#pragma unroll
        for (int i = 0; i < 4; ++i) { const int ct = 4 * (wave & 1) + i;
#pragma unroll
            for (int ks = 0; ks < 2; ++ks) acc[i] = mfma16(rowfrag(lds + HG_CUM, 144, 16 * rt, 32 * ks, lane), trfrag(lds + HG_VV, HP, 32 * ks, 16 * ct, lane), acc[i]);
#pragma unroll
            for (int ks = 0; ks < 4; ++ks) acc[i] = mfma16(rowfrag(lds + HG_QT, HP, 16 * rt, 32 * ks, lane), trfrag(lds + HG_SS, HP, 32 * ks, 16 * ct, lane), acc[i]); }
    }
    __syncthreads();
    LAS float* OB = (LAS float*)(lds + HG_CUM);
#pragma unroll
    for (int i = 0; i < 4; ++i)
#pragma unroll
        for (int r = 0; r < 4; ++r) OB[(16 * rt + 4 * (lane >> 4) + r) * 128 + 16 * (4 * (wave & 1) + i) + (lane & 15)] = acc[i][r];
    __syncthreads();
    { const int t = tid >> 3, v0 = (tid & 7) * 16; float o[16]; float ss = 0.f;
#pragma unroll
      for (int q = 0; q < 16; ++q) { o[q] = OB[t * 128 + v0 + q]; ss += o[q] * o[q]; }
      ss += SHX(ss, 1, lane); ss += SHX(ss, 2, lane); ss += SHX(ss, 4, lane);
      const float r = 1.0f / sqrtf(ss * (1.0f / 128.0f) + 1e-6f);
      const float* gain = a.p->in[I_HGNG] + j * 128 + v0;
      bf16_t* dst = WSP(bf16_t, WS_MIX) + (size_t)(c * HCH + t) * D + h * 128 + v0;
#pragma unroll
      for (int hh = 0; hh < 2; ++hh) { const u32x4 grr = gr[hh]; u32x4 w;
#pragma unroll
          for (int e = 0; e < 4; ++e) { const int q = hh * 8 + 2 * e; w[e] = pk2(o[q] * r * gain[q] * silu_f(bflo(grr[e])), o[q + 1] * r * gain[q + 1] * silu_f(bfhi(grr[e]))); }
          *(u32x4*)(dst + hh * 8) = w; } }
}
constexpr int SG_W = 0, SG_VN = 34816, SG_ST = 69632;
__device__ __forceinline__ void sg_unit(const KCtx& a, int j, int cs, LAS unsigned char* lds) {
    const int tid = TIDX(a), lane = tid & 63, wave = rfl(tid >> 6);
    const bf16_t* proj = WSP(bf16_t, WS_PROJ); const int row0 = cs * SGC;
    __syncthreads();
    { const int t = tid >> 2, qd = tid & 3; float s = 0.f, s2 = 0.f;
      for (int i = 0; i < 16; ++i) { const u32x4 raw = *(const u32x4*)(proj + (size_t)(row0 + t) * EVEN_IN + P_EVV + qd * 128 + i * 8);
#pragma unroll
          for (int e = 0; e < 4; ++e) { const float x0 = gelu_f(bflo(raw[e])), x1 = gelu_f(bfhi(raw[e])); s += x0 + x1; s2 += x0 * x0 + x1 * x1; } }
      s += SHX(s, 1, lane); s += SHX(s, 2, lane); s2 += SHX(s2, 1, lane); s2 += SHX(s2, 2, lane);
      const float mean = s * (1.0f / 512.0f), var = fmaxf(s2 * (1.0f / 512.0f) - mean * mean, 0.f);
      if (qd == 0) { ((LAS float*)(lds + SG_ST))[t * 2] = mean; ((LAS float*)(lds + SG_ST))[t * 2 + 1] = 1.0f / sqrtf(var + 1e-5f); } }
    for (int g = 0; g < 4; ++g) {
        __syncthreads();
        const bf16_t* sgw = WSP(bf16_t, WS_SGW) + (size_t)(j * 4 + g) * 16384;
#pragma unroll
        for (int i = 0; i < 4; ++i) { const int p = tid + NTHR * i, r = p >> 4, c8 = (p & 15) * 8;
            *(LAS u32x4*)(lds + SG_W + r * HP + c8 * 2) = *(const u32x4*)(sgw + r * 128 + c8);
            const u32x4 raw = *(const u32x4*)(proj + (size_t)(row0 + r) * EVEN_IN + P_EVV + g * 128 + c8);
            const float mean = ((LAS float*)(lds + SG_ST))[r * 2], rstd = ((LAS float*)(lds + SG_ST))[r * 2 + 1];
            const float* lg = a.p->in[I_SGLNG] + j * 512 + g * 128 + c8; const float* lb = a.p->in[I_SGLNB] + j * 512 + g * 128 + c8;
            u32x4 w;
#pragma unroll
            for (int e = 0; e < 4; ++e) w[e] = pk2((gelu_f(bflo(raw[e])) - mean) * rstd * lg[2 * e] + lb[2 * e], (gelu_f(bfhi(raw[e])) - mean) * rstd * lg[2 * e + 1] + lb[2 * e + 1]);
            *(LAS u32x4*)(lds + SG_VN + r * HP + c8 * 2) = w; }
        __syncthreads();
        f32x4 acc[8];
#pragma unroll
        for (int i = 0; i < 8; ++i) acc[i] = (f32x4){0.f, 0.f, 0.f, 0.f};
#pragma unroll
        for (int ks = 0; ks < 4; ++ks) { const bf16x8 af = rowfrag(lds + SG_W, HP, 16 * wave, 32 * ks, lane);
#pragma unroll
            for (int ct = 0; ct < 8; ++ct) acc[ct] = mfma16(af, trfrag(lds + SG_VN, HP, 32 * ks, 16 * ct, lane), acc[ct]); }
        const float* sb = a.p->in[I_SGB] + (size_t)(j * 4 + g) * 128;
#pragma unroll
        for (int r = 0; r < 4; ++r) { const int t = 16 * wave + 4 * (lane >> 4) + r; const float bias = sb[t];
            const bf16_t* up = proj + (size_t)(row0 + t) * EVEN_IN + P_EVU + g * 128 + (lane & 15); bf16_t* dst = WSP(bf16_t, WS_MIX) + (size_t)(row0 + t) * D + 512 + g * 128 + (lane & 15);
#pragma unroll
            for (int ct = 0; ct < 8; ++ct) dst[16 * ct] = (bf16_t)f2bf((acc[ct][r] + bias) * gelu_f(bf2f(up[16 * ct]))); }
    }
}

constexpr int AT_SLOT = 32768, AT_V = 16384, AT_L = 3 * AT_SLOT, AT_Q = AT_L + 4096;
__device__ __forceinline__ int crow(int r, int hi) { return (r & 3) + 8 * (r >> 2) + 4 * hi; }
#ifdef CPU_SIM
#define PIN_P(w, l) do {} while (0)
#else
#define PIN_P(w, l) asm volatile("" : "+v"(w[0]), "+v"(w[1]), "+v"(l))
#endif
#define AT_KF(kb, d0) (*(const LAS bf16x8*)((kb) + (2 * (d0)) * 1024))
#define AT_VF(dst, vbh, db, ss) do { const LAS unsigned char* vp_ = (vbh) + (db) * 4096 + (ss) * 1024; const s16x4 lo_ = ds_tr16(vp_), hh_ = ds_tr16(vp_ + 512); \
        dst = (bf16x8){lo_[0], lo_[1], lo_[2], lo_[3], hh_[0], hh_[1], hh_[2], hh_[3]}; } while (0)
#define AT_STEP(pN, kbN, MN, DOS, pM, wN, lacc, DOX, OACC, wO, vbO, KNEXT, kbNext, vbNext) do { \
    _Pragma("unroll") for (int q_ = 0; q_ < 4; ++q_) { \
        bf16x8 kfc_ = kf, kfn_ = kf, qq_ = vfa, vfan_, vfbn_; \
        if (q_ < 3) { if (DOS) kfn_ = AT_KF(kbN, q_ + 1); } else if (KNEXT) kfn_ = AT_KF(kbNext, 0); \
        if (DOS) { qq_ = (MN == 0 || AV == 2) ? qf[q_] : *(const LAS bf16x8*)(qb1 + q_ * 1024); } \
        if (AV == 2) { vfan_ = vfa; vfbn_ = vfb; } else \
        if (q_ < 3) { AT_VF(vfan_, vbO, q_ + 1, 0); AT_VF(vfbn_, vbO, (q_ + 3) & 3, 1); } else { AT_VF(vfan_, vbNext, 0, 0); AT_VF(vfbn_, vbNext, 2, 1); } \
        SCHED_FENCE();     \
        if (AV == 6) { bf16x8 d0_, d1_; if (q_ < 3) { AT_VF(d0_, vbO, q_ + 1, 1); AT_VF(d1_, vbO, (q_ + 3) & 3, 0); } else { AT_VF(d0_, vbNext, 0, 1); AT_VF(d1_, vbNext, 2, 0); } asm volatile("" :: "v"(d0_), "v"(d1_)); } \
        if (AV == 7) { bf16x8 d0_ = AT_KF(kbN, q_), d1_ = AT_KF(kbN, (q_ + 1) & 3); asm volatile("" :: "v"(d0_), "v"(d1_)); } \
        if (AV != 3) { OACC[q_] = mfma32(__builtin_bit_cast(bf16x8, wO[0]), vfa, OACC[q_]); OACC[(q_ + 2) & 3] = mfma32(__builtin_bit_cast(bf16x8, wO[1]), vfb, OACC[(q_ + 2) & 3]); } \
        if (DOS && AV != 4) { if (q_ == 0) pN = mfma32(kfc_, qq_, negmv); else pN = mfma32(kfc_, qq_, pN); } \
        if (DOX) { _Pragma("unroll") for (int r_ = 4 * q_; r_ < 4 * q_ + 4; ++r_) { if (AV != 1) pM[r_] = fexp2(pM[r_]); lacc += pM[r_]; } \
            wN[q_ >> 1][(q_ & 1) * 2] = pk2(pM[4 * q_], pM[4 * q_ + 1]); wN[q_ >> 1][(q_ & 1) * 2 + 1] = pk2(pM[4 * q_ + 2], pM[4 * q_ + 3]); } \
        vfa = vfan_; vfb = vfbn_; kf = kfn_; \
        SCHED_FENCE(); } \
    if (DOX) { PIN_P(wN, lacc); } } while (0)
template <int AV>
__device__ __forceinline__ void attn_unit(const KCtx& a, int j, int h, int q0, int nkeys, LAS unsigned char* lds) {
    int tid = FRESH_TID(a); OPAQUE(tid);
    const int lane = tid & 63, wid = a.wv, r32 = lane & 31, hi = lane >> 5;
    const bf16_t* QR = WSP(bf16_t, WS_QR); const bf16_t* KR = WSP(bf16_t, WS_KR) + h * 128; const bf16_t* VP = WSP(bf16_t, WS_PROJ) + 2048 + h * 128;
    const int qrow = q0 + wid * 32 + r32, NT = nkeys / 64;
    __syncthreads();
    int koff = (lane * D + wid * 8) * 2, voff = ((16 * (wid & 3) + (lane >> 2)) * DQKV + (wid >> 2) * 32 + (lane & 3) * 8) * 2;
    OPAQUE(koff); OPAQUE(voff);
#define DMA_TILE(t, slot) do { const unsigned char* ks_ = (const unsigned char*)KR + (size_t)(t) * 64 * D * 2; const unsigned char* vs_ = (const unsigned char*)VP + (size_t)(t) * 64 * DQKV * 2; \
        LAS unsigned char* sl_ = lds + (slot) * AT_SLOT + wid * 1024; \
        glds16s(ks_, koff, sl_); glds16s(ks_ + 128, koff, sl_ + 8192); glds16s(vs_, voff, sl_ + AT_V); glds16s(vs_ + 128, voff, sl_ + AT_V + 8192); } while (0)
    DMA_TILE(0, 0);
    if (NT > 1) DMA_TILE(1, 1);
    bf16x8 qf[4];
    int qbo = AT_Q + wid * 4096 + hi * 512 + r32 * 16; OPAQUE(qbo);
    const LAS unsigned char* qb1 = lds + qbo;
#pragma unroll
    for (int d0 = 0; d0 < 4; ++d0) { qf[d0] = *(const bf16x8*)(QR + (size_t)qrow * D + h * 128 + d0 * 16 + hi * 8);
        *(LAS bf16x8*)(lds + qbo + d0 * 1024) = *(const bf16x8*)(QR + (size_t)qrow * D + h * 128 + 64 + d0 * 16 + hi * 8); }
    float negm;
    { float qs0 = 0.f, qs1 = 0.f;
#pragma unroll
      for (int d0 = 0; d0 < 4; ++d0) { const bf16x8 q1f = *(const LAS bf16x8*)(qb1 + d0 * 1024);
#pragma unroll
          for (int e = 0; e < 8; ++e) { const float x0 = bf2f((bf16_t)qf[d0][e]), x1 = bf2f((bf16_t)q1f[e]); qs0 += x0 * x0; qs1 += x1 * x1; } }
      qs0 += SHX(qs0, 32, lane); qs1 += SHX(qs1, 32, lane);
      const unsigned* kbw = WSP(unsigned, WS_CTL) + CW_KB + j * 128 + h * 16; float k0 = 0.f, k1 = 0.f;
#pragma unroll
      for (int e = 0; e < 8; ++e) { k0 += __builtin_bit_cast(float, kbw[e]); k1 += __builtin_bit_cast(float, kbw[8 + e]); }
      negm = -(sqrtf(fmaxf(qs0, qs1)) * sqrtf(fmaxf(k0, k1)) * 1.0005f + 1e-3f); }
    f32x16 O0[4], O1[4];
#pragma unroll
    for (int i = 0; i < 4; ++i)
#pragma unroll
        for (int r = 0; r < 16; ++r) { O0[i][r] = 0.f; O1[i][r] = 0.f; }
    float l0 = 0.f, l1 = 0.f;
    f32x16 negmv;
#pragma unroll
    for (int r = 0; r < 16; ++r) negmv[r] = negm;
    int vb = AT_V + ((lane >> 4) & 1) * 32 + (lane & 3) * 8 + (4 * hi + ((lane & 15) >> 2)) * 64; OPAQUE(vb);
    int kbo = hi * 1024 + r32 * 16; OPAQUE(kbo);
    f32x16 pA, pB; u32x4 wA[2], wB[2]; bf16x8 vfa, vfb, kf;
    WAIT_DMA_BAR();
    int sc = 0, sn = AT_SLOT, sp = 2 * AT_SLOT;
    {
#pragma unroll
        for (int r = 0; r < 16; ++r) { pA[r] = negm; pB[r] = negm; }
#pragma unroll
        for (int d0 = 0; d0 < 4; ++d0) { pB = mfma32(AT_KF(lds + kbo, d0), qf[d0], pB); pA = mfma32(AT_KF(lds + kbo + 8192, d0), *(const LAS bf16x8*)(qb1 + d0 * 1024), pA); }
#pragma unroll
        for (int r = 0; r < 16; ++r) { pB[r] = fexp2(pB[r]); l0 += pB[r]; }
#pragma unroll
        for (int e = 0; e < 4; ++e) { wA[0][e] = pk2(pB[2 * e], pB[2 * e + 1]); wA[1][e] = pk2(pB[8 + 2 * e], pB[8 + 2 * e + 1]); }
        AT_VF(vfa, lds + vb, 0, 0); AT_VF(vfb, lds + vb, 2, 1); kf = AT_KF(lds + kbo + 512, 0);
    }
    for (int kt = 0; kt < NT; ++kt) {
        const bool more = kt + 1 < NT;
        SCHED_FENCE();
        const LAS unsigned char* kc = lds + kbo + sc; const LAS unsigned char* kn = lds + kbo + sn; const LAS unsigned char* vc = lds + vb + sc; const LAS unsigned char* vn = lds + vb + sn;
        AT_STEP(pB, kc + 512, 0, true, pA, wB, l1, true, O0, wA, vc, true, kc + 512 + 8192, vc);
        AT_STEP(pA, kc + 512 + 8192, 1, true, pB, wA, l0, true, O1, wB, vc, false, kc, vc + 2048);
        if (AV != 5) { WAIT_DMA_BAR_KEEP();
        if (kt + 2 < NT) DMA_TILE(kt + 2, (kt + 2) % 3); }
        if (more) { kf = AT_KF(kn, 0);
            AT_STEP(pB, kn, 0, true, pA, wB, l1, true, O0, wA, vc + 2048, true, kn + 8192, vc + 2048);
            AT_STEP(pA, kn + 8192, 1, true, pB, wA, l0, true, O1, wB, vc + 2048, true, kn + 512, vn);
        } else {
            AT_STEP(pB, kn, 0, false, pA, wB, l1, true, O0, wA, vc + 2048, false, kn, vc + 2048);
            AT_STEP(pA, kn, 1, false, pB, wA, l0, false, O1, wB, vc + 2048, false, kn, vc + 2048);
        }
        { const int t_ = sc; sc = sn; sn = sp; sp = t_; }
    }
#undef DMA_TILE
    SCHED_FENCE();
    int tid3 = FRESH_TID(a); OPAQUE(tid3);
    const int lane3 = tid3 & 63, wid3 = a.wv, r3 = lane3 & 31, hi3 = lane3 >> 5;
    LAS float* lb = (LAS float*)(lds + AT_L) + wid3 * 128;
    lb[hi3 * 32 + r3] = l0; lb[64 + hi3 * 32 + r3] = l1;
    WAVE_SYNC();
    const float lam = WSP(float, WS_SMALL + SM_LAMF)[j];
    const float lam_init = 0.8f - 0.6f * expf(-0.3f * (float)(2 * j + 1));
    const float* subg = a.p->in[I_DASUBG] + j * 128;
    bf16_t* dst = WSP(bf16_t, WS_MIX) + (size_t)(q0 + wid3 * 32) * D + h * 128 + r3;
#pragma unroll
    for (int r = 0; r < 16; ++r) { SCHED_FENCE(); const int q = crow(r, hi3); const float li0 = 1.0f / (lb[q] + lb[32 + q]), li1 = lam / (lb[64 + q] + lb[96 + q]);
        float o[4]; float ss = 0.f;
#pragma unroll
        for (int db = 0; db < 4; ++db) { o[db] = O0[db][r] * li0 - O1[db][r] * li1; ss += o[db] * o[db]; }
#pragma unroll
        for (int ofs = 1; ofs < 32; ofs <<= 1) ss += SHX(ss, ofs, lane3);
        const float rn = (1.0f - lam_init) / sqrtf(ss * (1.0f / 128.0f) + 1e-5f);
#pragma unroll
        for (int db = 0; db < 4; ++db) dst[(size_t)q * D + db * 32] = (bf16_t)f2bf(o[db] * rn * subg[db * 32 + r3]); }
}
template <int AV = 0>
__device__ __forceinline__ void ph_attn(const KCtx& a, int j, LAS unsigned char* lds) {
    constexpr int NQT = SEQ / 256;
    for (int u = a.bx; u < NQT * 8 + 8; u += a.G) {
        const bool lat = u < NQT * 8;
        attn_unit<AV>(a, j, lat ? (u & 7) : (u - NQT * 8), lat ? CTX + (u >> 3) * 256 : 0, lat ? T : CTX, lds);
    }
}

__device__ __forceinline__ void ph_moe_assign(const KCtx& a, int j) {
    const int tid = TIDX(a), lane = tid & 63, wave = rfl(tid >> 6), gw = a.bx * NWAVES + wave, NGW = a.G * NWAVES;
    unsigned* cnt = WSP(unsigned, WS_CTL) + CW_MOECNT + j * 64; unsigned* cur = WSP(unsigned, WS_CTL) + CW_MOECUR + j * 64;
    int start[NEXP + 1]; start[0] = 0;
#pragma unroll
    for (int e = 0; e < NEXP; ++e) start[e + 1] = start[e] + (int)((cnt[e] + 255u) / 256u) * 256;
    int* tab = WSP(int, WS_SMALL + SM_MOETAB);
    if (a.bx == 0 && tid == 0) { const int ntr = start[NEXP] / 256; tab[0] = ntr;
        for (int rt = 0; rt < ntr; ++rt) { int e = 0;
#pragma unroll
            for (int q = 1; q < NEXP; ++q) if (rt * 256 >= start[q]) e = q;
            tab[16 + rt] = e; } }
    const int* te = WSP(int, WS_TOK); int* tp = WSP(int, WS_TOK + (size_t)T * 16);
    const bf16_t* H = WSP(bf16_t, WS_H); bf16_t* AG = WSP(bf16_t, WS_AG);
    int mypos = 0;
    { const int idx = gw + lane * NGW;
      if (idx < 2 * T) { const int e = te[idx]; int st = 0;
#pragma unroll
          for (int q = 0; q < NEXP; ++q) if (q == e) st = start[q];
          mypos = st + (int)atomicAdd(cur + e, 1u); tp[idx] = mypos; } }
    int it = 0;
    for (int idx = gw; idx < 2 * T; idx += NGW, ++it) {
        const int pos = SHI(mypos, it, lane);
        const u32x4* src = (const u32x4*)((const unsigned char*)H + (size_t)(idx >> 1) * D); u32x4* dst = (u32x4*)((unsigned char*)AG + (size_t)pos * D);
        dst[lane] = src[lane];
    }
}

constexpr int N_PHASES = 38;
__global__ void __launch_bounds__(NTHR, 2) fwd_kernel(KArgs ka) {
#ifdef CPU_SIM
    unsigned char* lds = sim_lds();
#else
    extern __shared__ __attribute__((aligned(16))) unsigned char lds_raw[];
    LAS unsigned char* lds = (LAS unsigned char*)lds_raw;
#endif
    KCtx a;
#ifdef CPU_SIM
    a.p = &ka; a.wv = (int)threadIdx.x >> 6; a.tid = (int)threadIdx.x; a.bx = (int)blockIdx.x; a.G = (int)gridDim.x; a.L = lds;
#define NEWCTX() do {} while (0)
#else
    const int wv0 = rfl((int)threadIdx.x >> 6); a.wv = wv0;
#define NEWCTX() do { unsigned long long kp_ = (unsigned long long)__builtin_amdgcn_kernarg_segment_ptr(); asm volatile("" : "+s"(kp_)); a.p = (KArgP)kp_; \
        int b_ = (int)blockIdx.x, g_ = (int)gridDim.x, w_ = wv0, l_ = 0; asm volatile("" : "+s"(b_), "+s"(g_), "+s"(w_), "+s"(l_)); a.bx = b_; a.G = g_; a.wv = w_; a.L = lds + l_; \
        unsigned z2_ = 0u; asm volatile("" : "+s"(z2_)); int t_ = w_ * 64 + (int)__builtin_amdgcn_mbcnt_hi(~0u, __builtin_amdgcn_mbcnt_lo(~0u, z2_)); asm volatile("" : "+v"(t_)); a.tid = t_; } while (0)
    NEWCTX();
#endif
    const int tid = TIDX(a);
    for (int u = tid; u < (LDS_BYTES - LDS_MISC) / 4; u += NTHR) ((LAS unsigned*)(lds + LDS_MISC))[u] = 0u;
    __syncthreads();
#if !defined(CPU_SIM) && N_LAUNCH_MODE == 0
    XcdBarrier bar = xcd_barrier_post(WSP(unsigned, WS_CTL) + CW_BAR, (volatile LAS unsigned*)(lds + LDS_MISC + 32), tid);
#define SEAM() do { XcdBarrier b_ = bar; unsigned long long bp_ = (unsigned long long)b_.bar; unsigned bxx_ = b_.x; asm volatile("" : "+s"(bp_), "+s"(bxx_)); b_.bar = (unsigned*)bp_; b_.x = bxx_; xcd_barrier(b_, FRESH_TID(a)); } while (0)
#else
#define SEAM() do {} while (0)
#endif
    const int lo = a.p->ph_lo, hi = a.p->ph_hi;
#ifdef ONLY_SITE
#define SITE(k) (ONLY_SITE == (k))
#else
#define SITE(k) 1
#endif
#ifdef PROBE_SITE
#define REPS(k) ((PROBE_SITE == (k)) ? PROBE_REPS : 1)
#else
#define REPS(k) 1
#endif
#define IN(p) (lo <= (p) && (p) < hi)
#define ENDPH(p) do { if (IN((p) + 1)) SEAM(); } while (0)
#define ENDPH2(p) do { if (IN((p) + 2)) SEAM(); } while (0)
#define modv WSP(float, WS_SMALL + SM_MODV)
#define moetab WSP(int, WS_SMALL + SM_MOETAB)

    if (SITE(0) && IN(0)) { NEWCTX(); for (int rep_ = 0; rep_ < REPS(0); ++rep_) { ph_prologue(a, a.L); } ENDPH(0); }
    for (int pr = 0; pr < 2; ++pr) {
        const int j = pr, Le = 2 * pr, Lo = 2 * pr + 1, be = 1 + 9 * Le, bo = 1 + 9 * Lo;
        if (SITE(1) && IN(be + 0)) { NEWCTX(); for (int rep_ = 0; rep_ < REPS(1); ++rep_) { if (pr == 0) ph_rowpass<false, false, false, true>(a, Le, 0); else ph_rowpass<true, false, false>(a, Le, 0); } ENDPH(be + 0); }
        if (SITE(2) && IN(be + 1)) { NEWCTX(); for (int rep_ = 0; rep_ < REPS(2); ++rep_) {
            pg8::Gemm g{WSP(bf16_t, WS_H), WSP(bf16_t, WS_WIN + j * SZ_WIN), T, EVEN_IN, D}; pg8::StaticOrder S; S.init(T, EVEN_IN, a.G, a.bx);
            pg8::EpiStoreBf16 E{WSP(bf16_t, WS_PROJ), EVEN_IN, EVEN_IN / 256};
            pg8::gemm_phase<pg8::EpiStoreBf16, pg8::StaticOrder, true, true>(a.L, g, S, E, TIDX(a)); } ENDPH(be + 1); }
        if (SITE(3) && IN(be + 2)) { NEWCTX(); for (int rep_ = 0; rep_ < REPS(3); ++rep_) { for (int u = a.bx; u < NSG + NCH * 8; u += a.G) { if (u < NSG) sg_unit(a, j, u, a.L); else hg_unit_a(a, j, u - NSG, a.L); } } ENDPH(be + 2); }
        if (SITE(4) && IN(be + 3)) { NEWCTX(); for (int rep_ = 0; rep_ < REPS(4); ++rep_) { ph_hg_scan(a); } ENDPH(be + 3); }
        if (SITE(5) && IN(be + 4)) { NEWCTX(); for (int rep_ = 0; rep_ < REPS(5); ++rep_) { for (int u = a.bx; u < NCH * 4; u += a.G) hg_unit_c(a, j, u >> 2, u & 3, a.L); } ENDPH(be + 4); }
        if (SITE(6) && IN(be + 5)) { NEWCTX(); for (int rep_ = 0; rep_ < REPS(6); ++rep_) {
            pg8::Gemm g{WSP(bf16_t, WS_MIX) + (size_t)CTX * D, WSP(bf16_t, WS_WEO + j * SZ_WSQ), SEQ, D, D}; pg8::StaticOrder S; S.init(SEQ, D, a.G, a.bx);
            pg8::EpiResid E{pr == 0 ? a.p->in[I_X] : WSP(float, WS_X) + (size_t)CTX * D, WSP(float, WS_X1) + (size_t)CTX * D, modv + ((Le * 2 + 0) * 6 + 2) * 1024, modv + ((Le * 2 + 0) * 6 + 2) * 1024};
            pg8::gemm_phase<pg8::EpiResid, pg8::StaticOrder, true, true>(a.L, g, S, E, TIDX(a));
            ctx_gemm<1>(a, WSP(bf16_t, WS_MIX), WSP(bf16_t, WS_WEO + j * SZ_WSQ), D, D, nullptr, 0, pr == 0 ? a.p->in[I_CTX] : WSP(float, WS_X), WSP(float, WS_X1), modv + ((Le * 2 + 1) * 6 + 2) * 1024, a.L); } ENDPH(be + 5); }
        if (SITE(7) && IN(be + 6)) { NEWCTX(); for (int rep_ = 0; rep_ < REPS(7); ++rep_) { ph_rowpass<false, false, false>(a, Le, 1); } ENDPH(be + 6); }
        if (SITE(8) && IN(be + 7)) { NEWCTX(); for (int rep_ = 0; rep_ < REPS(8); ++rep_) {
            pg8::Gemm g{WSP(bf16_t, WS_H), WSP(bf16_t, WS_WGU + j * SZ_WGU), T, 2 * DFF, D}; pg8::StaticOrder S; S.init(T, 2 * DFF, a.G, a.bx);
            pg8::EpiSwiglu E{WSP(bf16_t, WS_HFF), DFF, 2 * DFF / 256};
            pg8::gemm_phase<pg8::EpiSwiglu, pg8::StaticOrder, true, true>(a.L, g, S, E, TIDX(a)); } ENDPH(be + 7); }
        if (SITE(9) && IN(be + 8)) { NEWCTX(); for (int rep_ = 0; rep_ < REPS(9); ++rep_) {
            pg8::Gemm g{WSP(bf16_t, WS_HFF) + (size_t)CTX * DFF, WSP(bf16_t, WS_WDN + j * SZ_WDN), SEQ, D, DFF}; pg8::StaticOrder S; S.init(SEQ, D, a.G, a.bx);
            pg8::EpiResid E{WSP(float, WS_X1) + (size_t)CTX * D, WSP(float, WS_X) + (size_t)CTX * D, modv + ((Le * 2 + 0) * 6 + 5) * 1024, modv + ((Le * 2 + 0) * 6 + 5) * 1024};
            pg8::gemm_phase<pg8::EpiResid, pg8::StaticOrder, true, true>(a.L, g, S, E, TIDX(a));
            ctx_gemm<1>(a, WSP(bf16_t, WS_HFF), WSP(bf16_t, WS_WDN + j * SZ_WDN), DFF, D, nullptr, 0, WSP(float, WS_X1), WSP(float, WS_X), modv + ((Le * 2 + 1) * 6 + 5) * 1024, a.L); } ENDPH(be + 8); }
        if (SITE(10) && IN(bo + 0)) { NEWCTX(); for (int rep_ = 0; rep_ < REPS(10); ++rep_) { ph_rowpass<false, false, false>(a, Lo, 0); if (pr == 1) { int itb = 0; moe_weights(a, 1, a.L, itb); } } ENDPH(bo + 0); }
        if (SITE(11) && IN(bo + 1)) { NEWCTX(); for (int rep_ = 0; rep_ < REPS(11); ++rep_) {
            pg8::Gemm g{WSP(bf16_t, WS_H) + (size_t)CTX * D, WSP(bf16_t, WS_WQKV + j * SZ_WQKV), SEQ, DQKV, D}; pg8::StaticOrder S; S.init(SEQ, DQKV, a.G, a.bx);
            pg8::EpiQkvRope E{WSP(bf16_t, WS_QR), WSP(bf16_t, WS_KR), WSP(bf16_t, WS_PROJ) + (size_t)CTX * DQKV, WSP(float, WS_SMALL + SM_ROPE), WSP(unsigned, WS_CTL) + CW_KB + j * 128};
            pg8::gemm_phase<pg8::EpiQkvRope, pg8::StaticOrder, true, true>(a.L, g, S, E, TIDX(a));
            ctx_gemm<3>(a, WSP(bf16_t, WS_H), WSP(bf16_t, WS_WQKV + j * SZ_WQKV), D, DQKV, WSP(bf16_t, WS_PROJ), DQKV, (const float*)(WSP(unsigned, WS_CTL) + CW_KB + j * 128), (float*)WSP(bf16_t, WS_QR), (const float*)WSP(bf16_t, WS_KR), a.L); } ENDPH2(bo + 1); }
        if (SITE(13) && IN(bo + 3)) { NEWCTX(); for (int rep_ = 0; rep_ < REPS(13); ++rep_) {
#ifdef PROBE_VARIANT
            if (a.p->variant != 0) ph_attn<PROBE_VARIANT>(a, j, a.L); else
#endif
            ph_attn<0>(a, j, a.L); } ENDPH(bo + 3); }
        if (SITE(14) && IN(bo + 4)) { NEWCTX(); for (int rep_ = 0; rep_ < REPS(14); ++rep_) {
            pg8::Gemm g{WSP(bf16_t, WS_MIX) + (size_t)CTX * D, WSP(bf16_t, WS_WAO + j * SZ_WSQ), SEQ, D, D}; pg8::StaticOrder S; S.init(SEQ, D, a.G, a.bx);
            pg8::EpiResid E{WSP(float, WS_X) + (size_t)CTX * D, WSP(float, WS_X1) + (size_t)CTX * D, modv + ((Lo * 2 + 0) * 6 + 2) * 1024, modv + ((Lo * 2 + 0) * 6 + 2) * 1024};
            pg8::gemm_phase<pg8::EpiResid, pg8::StaticOrder, true, true>(a.L, g, S, E, TIDX(a));
            ctx_gemm<1>(a, WSP(bf16_t, WS_MIX), WSP(bf16_t, WS_WAO + j * SZ_WSQ), D, D, nullptr, 0, WSP(float, WS_X), WSP(float, WS_X1), modv + ((Lo * 2 + 1) * 6 + 2) * 1024, a.L); } ENDPH(bo + 4); }
        if (SITE(15) && IN(bo + 5)) { NEWCTX(); for (int rep_ = 0; rep_ < REPS(15); ++rep_) { ph_rowpass<false, true, false>(a, Lo, 1); } ENDPH(bo + 5); }
        if (SITE(16) && IN(bo + 6)) { NEWCTX(); for (int rep_ = 0; rep_ < REPS(16); ++rep_) { ph_moe_assign(a, j); } ENDPH(bo + 6); }
        if (SITE(17) && IN(bo + 7)) { NEWCTX(); for (int rep_ = 0; rep_ < REPS(17); ++rep_) {
            pg8::Gemm g{WSP(bf16_t, WS_AG), WSP(bf16_t, WS_MGU), NR_MAX, 2 * EFF, D / 2}; pg8::MoeOrder S{moetab, 2 * EFF / 256, a.G, a.bx};
            pg8::EpiSwigluF8 E{WSP(unsigned char, WS_HM), EFF, 2 * EFF / 256, 1.0f / (F8_SH * F8_SW)};
            pg8::gemm_phase<pg8::EpiSwigluF8, pg8::MoeOrder, true, true>(a.L, g, S, E, TIDX(a)); } ENDPH(bo + 7); }
        if (SITE(18) && IN(bo + 8)) { NEWCTX(); for (int rep_ = 0; rep_ < REPS(18); ++rep_) {
            pg8::Gemm g{WSP(bf16_t, WS_HM), WSP(bf16_t, WS_MDN), NR_MAX, D, EFF / 2}; pg8::MoeOrder S{moetab, D / 256, a.G, a.bx};
            pg8::EpiStoreBf16S E{WSP(bf16_t, WS_Y), D, D / 256, 1.0f / (F8_SM * F8_SW)};
            pg8::gemm_phase<pg8::EpiStoreBf16S, pg8::MoeOrder, true, true>(a.L, g, S, E, TIDX(a)); } ENDPH(bo + 8); }
    }
    if (SITE(19) && IN(37)) { NEWCTX(); for (int rep_ = 0; rep_ < REPS(19); ++rep_) { ph_rowpass<true, false, true>(a, 3, 0); } }
#undef IN
#undef modv
#undef moetab
#undef ENDPH
#undef SEAM
}

#ifdef CPU_SIM
#ifndef SIM_GRID
#define SIM_GRID 16
#endif
int g_sim_ph_lo = 0, g_sim_ph_hi = N_PHASES;
extern "C" void kernel_launch(void* const* d_in, const int* in_sizes, int n_in, void* d_out, int out_size, void* d_ws, size_t ws_size, hipStream_t stream) {
    KArgs a{}; for (int i = 0; i < 26; ++i) a.in[i] = (const float*)d_in[i]; a.out = (float*)d_out; a.ws = (unsigned char*)d_ws;
    if (g_sim_ph_lo == 0) memset((char*)d_ws + WS_CTL, 0, CTL_BYTES);
    for (int p = g_sim_ph_lo; p < g_sim_ph_hi; ++p) { KArgs ap = a; ap.ph_lo = p; ap.ph_hi = p + 1;
        pg8::g_cur_phase = p; { static int once = 0; if (!once) { once = 1; const char* e = getenv("FP8_MASK"); if (e) pg8::g_fp8_mask = strtoull(e, nullptr, 0); const char* ea = getenv("FP8_SA"); if (ea) pg8::g_fp8_sa = atof(ea); const char* eb = getenv("FP8_SB"); if (eb) pg8::g_fp8_sb = atof(eb); fprintf(stderr, "[sim] fp8 mask %llx sa %g sb %g\n", pg8::g_fp8_mask, pg8::g_fp8_sa, pg8::g_fp8_sb); } }
        sim_launch([&]() { fwd_kernel(ap); }, SIM_GRID, NTHR, LDS_BYTES, 8); }
}
#else
extern "C" void kernel_launch(void* const* d_in, const int* in_sizes, int n_in, void* d_out, int out_size, void* d_ws, size_t ws_size, hipStream_t stream) {
    static int grid = 0;
    if (grid == 0) {
        if (n_in != 26 || out_size != SEQ * D || ws_size < WS_END) { fprintf(stderr, "kernel_launch: unexpected shapes (n_in %d out %d ws %zu need %zu)\n", n_in, out_size, ws_size, (size_t)WS_END); grid = -1; return; }
        int dev = 0, cus = 0;
        if (hipGetDevice(&dev) != hipSuccess || hipDeviceGetAttribute(&cus, hipDeviceAttributeMultiprocessorCount, dev) != hipSuccess) { grid = -1; return; }
        if (hipFuncSetAttribute((const void*)fwd_kernel, hipFuncAttributeMaxDynamicSharedMemorySize, LDS_BYTES) != hipSuccess) { fprintf(stderr, "kernel_launch: hipFuncSetAttribute failed\n"); grid = -1; return; }
        int per_cu = 0;
        if (hipOccupancyMaxActiveBlocksPerMultiprocessor(&per_cu, (const void*)fwd_kernel, NTHR, LDS_BYTES) != hipSuccess || per_cu < 1) fprintf(stderr, "kernel_launch: occupancy query says %d\n", per_cu);
        (void)hipGetLastError();
        grid = cus;
    }
    if (grid < 0) return;
    (void)hipMemsetAsync((char*)d_ws + WS_CTL, 0, CTL_BYTES, stream);
    KArgs a{};
    for (int i = 0; i < 26; ++i) a.in[i] = (const float*)d_in[i];
    a.out = (float*)d_out; a.ws = (unsigned char*)d_ws;
#if N_LAUNCH_MODE == 0 && defined(PROBE_PHASE) && defined(PROBE_VARIANT)
    a.variant = 0; a.ph_lo = 0; a.ph_hi = PROBE_PHASE;
    hipLaunchKernelGGL(fwd_kernel, dim3(grid), dim3(NTHR), LDS_BYTES, stream, a);
    for (int r = 1; r < PROBE_REPS; ++r) { (void)hipMemsetAsync((char*)d_ws + WS_CTL + CW_BAR * 4, 0, XCD_BAR_WORDS * 4, stream); a.variant = 1; a.ph_lo = PROBE_PHASE; a.ph_hi = PROBE_PHASE + 1;
        hipLaunchKernelGGL(fwd_kernel, dim3(grid), dim3(NTHR), LDS_BYTES, stream, a); }
    (void)hipMemsetAsync((char*)d_ws + WS_CTL + CW_BAR * 4, 0, XCD_BAR_WORDS * 4, stream); a.variant = 0; a.ph_lo = PROBE_PHASE; a.ph_hi = N_PHASES;
    hipLaunchKernelGGL(fwd_kernel, dim3(grid), dim3(NTHR), LDS_BYTES, stream, a);
#elif N_LAUNCH_MODE == 0 && defined(PROBE_PHASE)
    a.ph_lo = 0; a.ph_hi = PROBE_PHASE + 1;
    hipLaunchKernelGGL(fwd_kernel, dim3(grid), dim3(NTHR), LDS_BYTES, stream, a);
    for (int r = 1; r < PROBE_REPS; ++r) { (void)hipMemsetAsync((char*)d_ws + WS_CTL + CW_BAR * 4, 0, XCD_BAR_WORDS * 4, stream); a.ph_lo = PROBE_PHASE; a.ph_hi = PROBE_PHASE + 1;
        hipLaunchKernelGGL(fwd_kernel, dim3(grid), dim3(NTHR), LDS_BYTES, stream, a); }
    if (PROBE_PHASE + 1 < N_PHASES) { (void)hipMemsetAsync((char*)d_ws + WS_CTL + CW_BAR * 4, 0, XCD_BAR_WORDS * 4, stream); a.ph_lo = PROBE_PHASE + 1; a.ph_hi = N_PHASES;
        hipLaunchKernelGGL(fwd_kernel, dim3(grid), dim3(NTHR), LDS_BYTES, stream, a); }
#elif N_LAUNCH_MODE == 0
    a.ph_lo = 0; a.ph_hi = N_PHASES;
    hipLaunchKernelGGL(fwd_kernel, dim3(grid), dim3(NTHR), LDS_BYTES, stream, a);
#else
    for (int p = 0; p < N_PHASES; ++p) { a.ph_lo = p; a.ph_hi = p + 1; hipLaunchKernelGGL(fwd_kernel, dim3(grid), dim3(NTHR), LDS_BYTES, stream, a); }
#endif
}
#endif
```

```cpp
#ifdef CPU_SIM
#include "cpu_sim.h"
typedef void* hipStream_t;
#else
#include <hip/hip_runtime.h>
#include <cstdio>
#include <cstdint>
#endif
#include <cmath>

#ifndef SEQ_LEN
#define SEQ_LEN 16384
#endif
#ifndef N_LAUNCH_MODE
#define N_LAUNCH_MODE 0
#endif

typedef unsigned short bf16_t;
typedef short bf16x8 __attribute__((ext_vector_type(8)));
typedef short s16x4 __attribute__((ext_vector_type(4)));
typedef float f32x4 __attribute__((ext_vector_type(4)));
typedef float f32x2 __attribute__((ext_vector_type(2)));
typedef float f32x16 __attribute__((ext_vector_type(16)));
typedef unsigned u32x4 __attribute__((ext_vector_type(4)));
typedef unsigned u32x2 __attribute__((ext_vector_type(2)));

constexpr int D = 1024, SEQ = SEQ_LEN, CTX = 256, T = SEQ + CTX;
constexpr int GRID_W = 64;
constexpr int EVEN_IN = 3584, DFF = 2816, EFF = 3584, NEXP = 8, DQKV = 3072;
constexpr int HCH = 64, NCH = T / HCH, NCC = CTX / HCH;
constexpr int SGC = 128, NSG = T / SGC;
constexpr int NR_MAX = ((2 * T + NEXP * 255 + 255) / 256) * 256;
constexpr int NTR_MAX = NR_MAX / 256;
constexpr int NWAVES = 8, NTHR = 512;
constexpr float QSCALE = 0.125f * 1.4426950408889634f;

constexpr size_t MiB = 1u << 20;
constexpr size_t al1(size_t x) { return (x + MiB - 1) / MiB * MiB; }
constexpr size_t WS_CTL = 0, CTL_BYTES = 1 * MiB;
constexpr size_t WS_SMALL = WS_CTL + CTL_BYTES;
constexpr size_t WS_TOK = WS_SMALL + 1 * MiB;
constexpr size_t WS_QN = WS_TOK + al1((size_t)T * 24);
constexpr size_t WS_HGD = WS_QN + al1((size_t)T * 32);
constexpr size_t WS_WIN = WS_HGD + al1((size_t)NCH * 8 * 512);
constexpr size_t SZ_WIN = (size_t)EVEN_IN * D * 2, SZ_WSQ = (size_t)D * D * 2, SZ_WGU = (size_t)2 * DFF * D * 2, SZ_WDN = (size_t)D * DFF * 2, SZ_WQKV = (size_t)DQKV * D * 2;
constexpr size_t WS_WEO = WS_WIN + 2 * SZ_WIN, WS_WGU = WS_WEO + 2 * SZ_WSQ, WS_WDN = WS_WGU + 2 * SZ_WGU, WS_WQKV = WS_WDN + 2 * SZ_WDN, WS_WAO = WS_WQKV + 2 * SZ_WQKV;
constexpr size_t WS_SGW = WS_WAO + 2 * SZ_WSQ;
constexpr size_t WS_MGU = al1(WS_SGW + 2 * 4 * 128 * 128 * 2);
constexpr size_t SZ_MGU = (size_t)NEXP * 2 * EFF * D * 2, SZ_MDN = (size_t)NEXP * D * EFF * 2;
constexpr size_t WS_MDN = WS_MGU + SZ_MGU;
constexpr size_t WS_X = al1(WS_MDN + SZ_MDN);
constexpr size_t WS_H = WS_X + al1((size_t)T * D * 4);
constexpr size_t WS_B = WS_H + al1((size_t)T * D * 2);
constexpr size_t WS_PROJ = WS_B;
constexpr size_t WS_HGU = WS_PROJ + al1((size_t)T * EVEN_IN * 2);
constexpr size_t WS_QR = WS_PROJ + al1((size_t)T * DQKV * 2);
constexpr size_t WS_KR = WS_QR + al1((size_t)T * D * 2);
constexpr size_t WS_MIX = WS_HGU + al1((size_t)NCH * 8 * 65536);
constexpr size_t WS_HFF = WS_B;
constexpr size_t WS_AG = WS_B;
constexpr size_t WS_HM = WS_AG + al1((size_t)NR_MAX * D * 2);
constexpr size_t WS_Y = WS_HM + al1((size_t)NR_MAX * EFF * 2);
constexpr size_t WS_END_A = WS_MIX + al1((size_t)T * D * 2), WS_END_B = WS_Y + al1((size_t)NR_MAX * D * 2);
constexpr size_t WS_END0 = WS_END_A > WS_END_B ? WS_END_A : WS_END_B;
constexpr size_t WS_HGS = WS_END0;
constexpr size_t WS_X1 = WS_HGS + al1((size_t)NCH * 8 * 65536);
constexpr size_t WS_END = WS_X1 + al1((size_t)T * D * 4);
static_assert(WS_KR + al1((size_t)T * D * 2) <= WS_MIX, "odd-layer q/k buffers below the mixer output");
constexpr int CW_BAR = 4096;
constexpr int CW_MOECNT = 8192, CW_MOECUR = 8192 + 128, CW_KMAX = 8192 + 256, CW_MOEWQ = 8192 + 384, CW_KB = 8192 + 512;
constexpr size_t SM_MODV = 0, SM_ROPE = 256 * 1024  , SM_LAMF = 512 * 1024, SM_MOETAB = 768 * 1024;

constexpr int LDS_MISC = 143360, LDS_BYTES = 147456;

#ifdef CPU_SIM
#define LAS
#define GAS
#define WAVE_SYNC() sim_wave_sync()
#define VM_WAIT()
static inline f32x16 mfma32(bf16x8 a, bf16x8 b, f32x16 c) { return sim_mfma32x32x16(a, b, c); }
static inline f32x4 mfma16(bf16x8 a, bf16x8 b, f32x4 c) { return sim_mfma16x16x32(a, b, c); }
static inline s16x4 ds_tr16(const unsigned char* p) { return sim_ds_read_tr16(p); }
static inline float fexp2(float x) { return exp2f(x); }
static inline float frcp(float x) { return 1.0f / x; }
static inline float frsq(float x) { return 1.0f / sqrtf(x); }
static inline int rfl(int x) { return x; }
#define OPAQUE(x) do {} while (0)
#define SETPRIO(n) do {} while (0)
#define BURN(x) do {} while (0)
#define SCHED_FENCE() do {} while (0)
static inline void glds16(const void* gsrc, unsigned char* wave_dst) { memcpy(wave_dst + (threadIdx.x & 63) * 16, gsrc, 16); }
static inline void glds16s(const void* sbase, unsigned voff, unsigned char* wave_dst) { memcpy(wave_dst + (threadIdx.x & 63) * 16, (const unsigned char*)sbase + voff, 16); }
#define WAIT_DMA_BAR() __syncthreads()
#define WAIT_DMA_BAR_KEEP() __syncthreads()
#else
#define LAS __attribute__((address_space(3)))
#define GAS __attribute__((address_space(1)))
#define WAVE_SYNC() asm volatile("s_waitcnt lgkmcnt(0)" ::: "memory")
#define VM_WAIT() asm volatile("s_waitcnt vmcnt(0)" ::: "memory")
typedef short v4i16_t __attribute__((ext_vector_type(4)));
__device__ __forceinline__ f32x16 mfma32(bf16x8 a, bf16x8 b, f32x16 c) { return __builtin_amdgcn_mfma_f32_32x32x16_bf16(a, b, c, 0, 0, 0); }
__device__ __forceinline__ f32x4 mfma16(bf16x8 a, bf16x8 b, f32x4 c) { return __builtin_amdgcn_mfma_f32_16x16x32_bf16(a, b, c, 0, 0, 0); }
__device__ __forceinline__ s16x4 ds_tr16(const LAS unsigned char* p) { return __builtin_bit_cast(s16x4, __builtin_amdgcn_ds_read_tr16_b64_v4i16((LAS v4i16_t*)p)); }
__device__ __forceinline__ float fexp2(float x) { return __builtin_amdgcn_exp2f(x); }
__device__ __forceinline__ float frcp(float x) { return __builtin_amdgcn_rcpf(x); }
__device__ __forceinline__ float frsq(float x) { return __builtin_amdgcn_rsqf(x); }
__device__ __forceinline__ int rfl(int x) { return __builtin_amdgcn_readfirstlane(x); }
#define OPAQUE(x) asm volatile("" : "+v"(x))
#define SETPRIO(n) __builtin_amdgcn_s_setprio(n)
#define BURN(x) do { float d_; asm volatile("v_exp_f32 %0, %1" : "=v"(d_) : "v"(x)); } while (0)
#define SCHED_FENCE() __builtin_amdgcn_sched_barrier(0)
__device__ __forceinline__ void glds16(const void* gsrc, LAS unsigned char* wave_dst) { unsigned keep; const unsigned d = (unsigned)__builtin_amdgcn_readfirstlane((int)(unsigned)(uintptr_t)wave_dst);
    asm volatile("s_mov_b32 %0, m0\n\ts_mov_b32 m0, %2\n\ts_nop 0\n\tglobal_load_lds_dwordx4 %1, off\n\ts_mov_b32 m0, %0" : "=&s"(keep) : "v"(gsrc), "s"(d) : "memory"); }
__device__ __forceinline__ void glds16s(const void* sbase, unsigned voff, LAS unsigned char* wave_dst) { unsigned keep; const unsigned d = (unsigned)__builtin_amdgcn_readfirstlane((int)(unsigned)(uintptr_t)wave_dst);
    asm volatile("s_mov_b32 %0, m0\n\ts_mov_b32 m0, %3\n\ts_nop 0\n\tglobal_load_lds_dwordx4 %1, %2\n\ts_mov_b32 m0, %0" : "=&s"(keep) : "v"(voff), "s"(sbase), "s"(d) : "memory"); }
#define WAIT_DMA_BAR() asm volatile("s_waitcnt vmcnt(0) lgkmcnt(0)\n\ts_barrier" ::: "memory")
#define WAIT_DMA_BAR_KEEP() asm volatile("s_waitcnt vmcnt(0)\n\ts_barrier" ::: "memory")
#endif

__device__ __forceinline__ unsigned f2bf(float f) { unsigned u = __builtin_bit_cast(unsigned, f); return (u + 0x7fffu + ((u >> 16) & 1u)) >> 16; }
#ifdef CPU_SIM
__device__ __forceinline__ unsigned pk2(float lo, float hi) { return f2bf(lo) | (f2bf(hi) << 16); }
#else
typedef __bf16 hw_bf16x2 __attribute__((ext_vector_type(2)));
__device__ __forceinline__ unsigned pk2(float lo, float hi) { const f32x2 v = {lo, hi}; return __builtin_bit_cast(unsigned, __builtin_convertvector(v, hw_bf16x2)); }
#endif
constexpr float F8_SH = 8.0f, F8_SW = 256.0f, F8_SM = 4.0f;
#ifdef CPU_SIM
static inline unsigned f2e4m3(float x) { unsigned sgn = x < 0 ? 0x80u : 0u; float ax = fabsf(x); if (!(ax == ax)) return sgn | 0x7fu; if (ax >= 448.f) return sgn | 0x7eu;
    if (ax < 0.015625f) { const int m = (int)rintf(ax * 512.f); return sgn | (unsigned)m; }
    int e; const float fr = frexpf(ax, &e); int m = (int)rintf(fr * 16.f); if (m == 16) { m = 8; ++e; } const int E = e - 1 + 7; if (E > 15 || (E == 15 && m - 8 > 6)) return sgn | 0x7eu; return sgn | (unsigned)(E << 3) | (unsigned)(m - 8); }
static inline float e4m32f(unsigned b) { const int E = (b >> 3) & 15, m = b & 7; float v = E == 0 ? ldexpf((float)m, -9) : ldexpf((float)(8 + m), E - 7 - 3); if (E == 15 && m == 7) v = NAN; return (b & 0x80u) ? -v : v; }
__device__ __forceinline__ unsigned pk4_f8(float a, float b, float c, float d) { return f2e4m3(a) | (f2e4m3(b) << 8) | (f2e4m3(c) << 16) | (f2e4m3(d) << 24); }
#else
__device__ __forceinline__ float f8clamp(float x) { return __builtin_amdgcn_fmed3f(x, -448.0f, 448.0f); }
__device__ __forceinline__ unsigned pk4_f8(float a, float b, float c, float d) { int w = 0; w = __builtin_amdgcn_cvt_pk_fp8_f32(f8clamp(a), f8clamp(b), w, false); w = __builtin_amdgcn_cvt_pk_fp8_f32(f8clamp(c), f8clamp(d), w, true); return (unsigned)w; }
#endif
__device__ __forceinline__ float bf2f(unsigned short b) { return __builtin_bit_cast(float, ((unsigned)b) << 16); }
__device__ __forceinline__ float bflo(unsigned w) { return __builtin_bit_cast(float, w << 16); }
__device__ __forceinline__ float bfhi(unsigned w) { return __builtin_bit_cast(float, w & 0xffff0000u); }
__device__ __forceinline__ float silu_f(float x) { return x * frcp(1.0f + __expf(-x)); }
__device__ __forceinline__ float sigm_f(float x) { return frcp(1.0f + __expf(-x)); }
__device__ __forceinline__ float gelu_f(float x) {
    const float t = frcp(fabsf(x) * 0.2316418882f + 1.0f);
    float q = t * 0.5307027145f + (-0.7265760135f); q = q * t + 0.7107068705f; q = q * t + (-0.142248368f); q = q * t + 0.127414796f; q = q * t;
    const float m = x * (q * fexp2(x * x * (-0.72134752044f)));
    return x < 0.f ? m : x - m;
}
#ifdef CPU_SIM
#define SHX(v, m, lane) __shfl_xor((v), (m))
#define SHI(v, src, lane) __shfl((v), (src))
#define SHC(v, srclane) __shfl((v), (srclane))
#define PARTNER32(v, lane) __shfl_xor((v), 32)
#else
__device__ __forceinline__ float shx_f(float v, int m, int lane) { return __builtin_bit_cast(float, __builtin_amdgcn_ds_bpermute((lane ^ m) << 2, __builtin_bit_cast(int, v))); }
__device__ __forceinline__ int shi_i(int v, int src) { return __builtin_amdgcn_ds_bpermute(src << 2, v); }
#define SHX(v, m, lane) shx_f((v), (m), (lane))
#define SHI(v, src, lane) shi_i((v), (src))
#define SHC(v, srclane) __builtin_bit_cast(float, __builtin_amdgcn_readlane(__builtin_bit_cast(int, (v)), (srclane)))
__device__ __forceinline__ float partner32_f(float v, int lane) { const unsigned u = __builtin_bit_cast(unsigned, v); auto r = __builtin_amdgcn_permlane32_swap(u, u, false, false); return __builtin_bit_cast(float, (lane & 32) ? r[0] : r[1]); }
#define PARTNER32(v, lane) partner32_f((v), (lane))
#endif
__device__ __forceinline__ float wave_sum(float v, int lane) {
#pragma unroll
    for (int o = 1; o < 64; o <<= 1) v += SHX(v, o, lane);
    return v;
}
#undef N_LAUNCH_MODE
#define N_LAUNCH_MODE 0
namespace pg8 {
#ifdef CPU_SIM
constexpr int BM = 256, BK = 64, HALF = 128, NXCD = 8, WGM = 8;
static int g_cur_phase = -1; static unsigned long long g_fp8_mask = 0; static float g_fp8_sa = 8.f, g_fp8_sb = 256.f;
static inline float q_e4m3(float x) { if (!(x == x)) return x; float ax = fabsf(x); if (ax >= 448.f) return x < 0 ? -448.f : 448.f; if (ax < 0.015625f) { float r = rintf(ax * 512.f) / 512.f; return x < 0 ? -r : r; } int e; frexpf(ax, &e); float ulp = ldexpf(1.f, e - 1 - 3); float r = rintf(ax / ulp) * ulp; if (r > 448.f) r = 448.f; return x < 0 ? -r : r; }
static float* g_qtab[2] = {nullptr, nullptr}; static float g_qtab_s[2] = {0.f, 0.f};
static inline const float* fp8_tab(int which, float s) { if (g_qtab[which] && g_qtab_s[which] == s) return g_qtab[which]; if (!g_qtab[which]) g_qtab[which] = (float*)malloc(65536 * 4); for (int i = 0; i < 65536; ++i) g_qtab[which][i] = q_e4m3(bf2f((bf16_t)i) * s) / s; g_qtab_s[which] = s; return g_qtab[which]; }
struct Unit { int pm, pn; };
struct Gemm { const bf16_t* A; const bf16_t* Bt; int M, N, K; };
struct StaticOrder {
    int nM, nN, nwg, G, c;
    void init(int M, int N, int G_, int c_) { nM = M / BM; nN = N / BM; nwg = nM * nN; G = G_; c = c_; }
    bool next(int i, Unit& u) const {
        const long L = (long)i * G + c; if (L >= nwg) return false;
        int wgid = (int)L; { const int q = nwg / NXCD, r = nwg % NXCD, xcd = wgid % NXCD, off = wgid / NXCD; wgid = (xcd < r ? xcd * (q + 1) : r * (q + 1) + (xcd - r) * q) + off; }
        const int nig = WGM * nN, gid = wgid / nig, fm = gid * WGM, gsz = (nM - fm) < WGM ? (nM - fm) : WGM;
        u.pm = fm + ((wgid % nig) % gsz); u.pn = (wgid % nig) / gsz; return true;
    }
    void a_ready(const Unit&) const {}
    void done(const Unit&) const {}
};
template <class Epi, class Sched, bool ALIGN_EPI = false, bool SP2 = false>
inline void gemm_phase(unsigned char* lds, const Gemm g, const Sched& S, const Epi& E, const int tid_in) {
    const int tid = threadIdx.x, wid = tid >> 6, lane = tid & 63, wr = wid >> 2, wc = wid & 3, fr = lane & 15, fq = lane >> 4;
    Unit cur;
    const bool f8 = g_cur_phase >= 0 && ((g_fp8_mask >> g_cur_phase) & 1ull); const float* qa = f8 ? fp8_tab(0, g_fp8_sa) : nullptr; const float* qb = f8 ? fp8_tab(1, g_fp8_sb) : nullptr;
    for (int ui = 0; S.next(ui, cur); ++ui) {
        f32x4 acc[2][2][4][2];
        for (int ai = 0; ai < 2; ++ai) for (int bj = 0; bj < 2; ++bj) for (int m = 0; m < 4; ++m) for (int n = 0; n < 2; ++n) for (int j = 0; j < 4; ++j) {
            const int r = 256 * cur.pm + 128 * ai + 64 * wr + 16 * m + fr;
            const int c = 256 * cur.pn + 128 * bj + 32 * wc + (Epi::PERM ? (8 * fq + 4 * n + j) : (16 * n + 4 * fq + j));
            const bf16_t* a = g.A + (size_t)r * g.K; const bf16_t* b = g.Bt + (size_t)c * g.K; float s = 0.f;
            if (Epi::F8) { const unsigned char* a8 = (const unsigned char*)g.A + (size_t)r * g.K * 2; const unsigned char* b8 = (const unsigned char*)g.Bt + (size_t)c * g.K * 2; for (int k = 0; k < 2 * g.K; ++k) s += e4m32f(a8[k]) * e4m32f(b8[k]); } else
            if (f8) { for (int k = 0; k < g.K; ++k) s += qa[a[k]] * qb[b[k]]; } else
            for (int k = 0; k < g.K; ++k) s += bf2f(a[k]) * bf2f(b[k]);
            acc[ai][bj][m][n][j] = s;
        }
        E(acc, cur, wr, wc, fr, fq);
    }
    __syncthreads();
}
#else
#define PG8_LAS __attribute__((address_space(3)))
constexpr int BM = 256, BK = 64, HALF = 128, HTB = HALF * BK * 2  , STAGE_BYTES = 8 * HTB, NXCD = 8, WGM = 8;

__host__ __device__ __forceinline__ int lds_byte(int r, int c) { const int st = (r >> 4) * 2 + (c >> 5), rr = r & 15, cc = c & 31, ob = rr * 64 + cc * 2; return st * 1024 + (ob ^ (((ob >> 9) & 1) << 5)); }
__host__ __device__ __forceinline__ void stage_rc(int b, int& R, int& C) { const int st = b / 1024, sb = b % 1024, swz = sb ^ (((sb >> 9) & 1) << 5); R = (st >> 1) * 16 + swz / 64; C = (st & 1) * 32 + (swz % 64) / 2; }
__host__ __device__ __forceinline__ int perm32(int rho) { const int n = rho >> 4, i = rho & 15; return 8 * (i >> 2) + 4 * n + (i & 3); }

struct Unit { int pm, pn; };
struct Gemm { const bf16_t* A; const bf16_t* Bt; int M, N, K; };

struct StaticOrder {
    int nM, nN, nwg, G, c;
    __host__ __device__ void init(int M, int N, int G_, int c_) { nM = M / BM; nN = N / BM; nwg = nM * nN; G = G_; c = c_; }
    __host__ __device__ bool next(int i, Unit& u) const {
        const long L = (long)i * G + c; if (L >= nwg) return false;
        int wgid = (int)L; { const int q = nwg / NXCD, r = nwg % NXCD, xcd = wgid % NXCD, off = wgid / NXCD; wgid = (xcd < r ? xcd * (q + 1) : r * (q + 1) + (xcd - r) * q) + off; }
        const int nig = WGM * nN, gid = wgid / nig, fm = gid * WGM, gsz = (nM - fm) < WGM ? (nM - fm) : WGM;
        u.pm = fm + ((wgid % nig) % gsz); u.pn = (wgid % nig) / gsz; return true;
    }
    __device__ __forceinline__ void a_ready(const Unit&) const {}
    __device__ __forceinline__ void done(const Unit&) const {}
};

typedef int pg8_i32x4 __attribute__((ext_vector_type(4))); typedef int pg8_i32x8 __attribute__((ext_vector_type(8)));
__device__ __forceinline__ pg8_i32x8 pg8_cat(bf16x8 lo, bf16x8 hi) { const pg8_i32x4 a = __builtin_bit_cast(pg8_i32x4, lo), b = __builtin_bit_cast(pg8_i32x4, hi); return __builtin_shufflevector(a, b, 0, 1, 2, 3, 4, 5, 6, 7); }
template <class Epi, class Sched, bool ALIGN_EPI = false, bool SP2 = false>
__device__ __forceinline__ void gemm_phase(PG8_LAS unsigned char* lds, const Gemm g, const Sched& S, const Epi& E, const int tid_in) {
    const int tid = tid_in, wid = __builtin_amdgcn_readfirstlane(tid >> 6), lane = tid & 63, wr = wid >> 2, wc = wid & 3, fr = lane & 15, fq = lane >> 4;
    const int K = g.K, nt = K / BK;
    unsigned voffA[2], voffB[2];
#pragma unroll
    for (int i = 0; i < 2; ++i) { int R, C; stage_rc(tid * 16 + i * 8192, R, C); const int Rb = Epi::PERM ? ((R & ~31) + perm32(R & 31)) : R;
        voffA[i] = (unsigned)(R * K + C) * 2u; voffB[i] = (unsigned)(Rb * K + C) * 2u; }
    const size_t kstep = (size_t)(BK * 2);
    const size_t hstep = (size_t)HALF * K * 2;
    const size_t tstep = 2 * hstep;
    const unsigned ldsw = (unsigned)wid * 1024u;
    const int aoff = lds_byte(wr * 64 + fr, fq * 8), boff = lds_byte(wc * 32 + fr, fq * 8);
#define PG8_SA(b, h) (((b) * 2 + (h)) * HTB)
#define PG8_SB(b, h) ((4 + (b) * 2 + (h)) * HTB)
#define PG8_STAGE(bufoff, gbase, voff) do { _Pragma("unroll") for (int _i = 0; _i < 2; ++_i) \
        __builtin_amdgcn_global_load_lds((const unsigned*)((const char*)(gbase) + (voff)[_i]), (PG8_LAS unsigned*)(lds + (bufoff) + ldsw + _i * 8192), 16, 0, 0); } while (0)
#define PG8_LDA(dst, b, h) do { _Pragma("unroll") for (int m = 0; m < 4; ++m) _Pragma("unroll") for (int k = 0; k < 2; ++k) dst[m][k] = *(const PG8_LAS bf16x8*)(lds + PG8_SA(b, h) + aoff + m * 2048 + k * 1024); } while (0)
#define PG8_LDB(dst, b, h) do { _Pragma("unroll") for (int n = 0; n < 2; ++n) _Pragma("unroll") for (int k = 0; k < 2; ++k) dst[n][k] = *(const PG8_LAS bf16x8*)(lds + PG8_SB(b, h) + boff + n * 2048 + k * 1024); } while (0)
#define PG8_MMA(ai, bj, At, Bt) do { __builtin_amdgcn_s_setprio(1); if constexpr (Epi::F8) { _Pragma("unroll") for (int m = 0; m < 4; ++m) _Pragma("unroll") for (int n = 0; n < 2; ++n) \
        asm volatile("v_mfma_f32_16x16x128_f8f6f4 %0, %1, %2, %0" : "+v"(acc[ai][bj][m][n]) : "v"(pg8_cat(Bt[n][0], Bt[n][1])), "v"(pg8_cat(At[m][0], At[m][1]))); } else { \
        _Pragma("unroll") for (int m = 0; m < 4; ++m) _Pragma("unroll") for (int n = 0; n < 2; ++n) _Pragma("unroll") for (int k = 0; k < 2; ++k) \
        acc[ai][bj][m][n] = __builtin_amdgcn_mfma_f32_16x16x32_bf16(Bt[n][k], At[m][k], acc[ai][bj][m][n], 0, 0, 0); } __builtin_amdgcn_s_setprio(0); } while (0)
#define PG8_WAIT_V(n) asm volatile("s_waitcnt vmcnt(" #n ")" ::: "memory")
#define PG8_WAIT_L(n) asm volatile("s_waitcnt lgkmcnt(" #n ")" ::: "memory")
#define PG8_BAR __builtin_amdgcn_s_barrier()
#define PG8_SCHED __builtin_amdgcn_sched_barrier(0)
    Unit cur, nxt; int ui = 0;
    if (!S.next(0, cur)) return;
    f32x4 acc[2][2][4][2];
#pragma unroll
    for (int a = 0; a < 2; ++a)
#pragma unroll
        for (int b = 0; b < 2; ++b)
#pragma unroll
            for (int m = 0; m < 4; ++m)
#pragma unroll
                for (int n = 0; n < 2; ++n) acc[a][b][m][n] = (f32x4){0.f, 0.f, 0.f, 0.f};
    bf16x8 At[4][2], B0[2][2], B1[2][2];
    const char* cA = (const char*)g.A + (size_t)cur.pm * tstep; const char* cB = (const char*)g.Bt + (size_t)cur.pn * tstep;
    S.a_ready(cur);
    if constexpr (SP2) {
        PG8_STAGE(PG8_SB(0, 0), cB, voffB); PG8_STAGE(PG8_SB(0, 1), cB + hstep, voffB); PG8_STAGE(PG8_SA(0, 0), cA, voffA); PG8_STAGE(PG8_SA(0, 1), cA + hstep, voffA);
        if (wr == 1) PG8_BAR;
        PG8_WAIT_V(2); PG8_BAR;
        PG8_STAGE(PG8_SB(1, 0), cB + kstep, voffB); PG8_STAGE(PG8_SA(1, 0), cA + kstep, voffA); PG8_STAGE(PG8_SB(1, 1), cB + hstep + kstep, voffB);
        PG8_WAIT_V(6); PG8_BAR;
    } else {
        PG8_STAGE(PG8_SB(0, 0), cB, voffB); PG8_STAGE(PG8_SA(0, 0), cA, voffA); PG8_STAGE(PG8_SB(0, 1), cB + hstep, voffB); PG8_STAGE(PG8_SA(0, 1), cA + hstep, voffA);
        if (wr == 1) PG8_BAR;
        PG8_WAIT_V(4); PG8_BAR;
        PG8_STAGE(PG8_SB(1, 0), cB + kstep, voffB); PG8_STAGE(PG8_SA(1, 0), cA + kstep, voffA); PG8_STAGE(PG8_SB(1, 1), cB + hstep + kstep, voffB);
        PG8_WAIT_V(6); PG8_BAR;
    }
    for (;;) {
        const bool has_next = S.next(ui + 1, nxt);
        const char* nA = has_next ? (const char*)g.A + (size_t)nxt.pm * tstep : cA; const char* nB = has_next ? (const char*)g.Bt + (size_t)nxt.pn * tstep : cB;
        _Pragma("nounroll") for (int t = 0; t < nt; t += 2) {
            const bool last = (t == nt - 2);
            const char* a1 = cA + (size_t)(t + 1) * kstep;
            const char* a2 = last ? nA : cA + (size_t)(t + 2) * kstep; const char* b2 = last ? nB : cB + (size_t)(t + 2) * kstep;
            const char* a3 = a2 + kstep; const char* b3 = b2 + kstep;
            if (last && has_next) S.a_ready(nxt);
            if constexpr (SP2) {
            PG8_LDB(B0, 0, 0); PG8_LDB(B1, 0, 1); PG8_SCHED; PG8_LDA(At, 0, 0); PG8_STAGE(PG8_SA(1, 1), a1 + hstep, voffA);
            PG8_WAIT_V(8); PG8_WAIT_L(0); PG8_BAR; PG8_MMA(0, 0, At, B0); PG8_MMA(0, 1, At, B1); PG8_BAR; PG8_SCHED;
            PG8_LDA(At, 0, 1); PG8_STAGE(PG8_SB(0, 0), b2, voffB); PG8_STAGE(PG8_SB(0, 1), b2 + hstep, voffB); PG8_STAGE(PG8_SA(0, 0), a2, voffA);
            PG8_WAIT_V(8); PG8_WAIT_L(0); PG8_BAR; PG8_MMA(1, 0, At, B0); PG8_MMA(1, 1, At, B1); PG8_BAR; PG8_SCHED;
            PG8_LDB(B0, 1, 0); PG8_LDB(B1, 1, 1); PG8_SCHED; PG8_LDA(At, 1, 0); PG8_STAGE(PG8_SA(0, 1), a2 + hstep, voffA);
            PG8_WAIT_V(8); PG8_WAIT_L(0); PG8_BAR; PG8_MMA(0, 0, At, B0); PG8_MMA(0, 1, At, B1); PG8_BAR; PG8_SCHED;
            PG8_LDA(At, 1, 1); PG8_STAGE(PG8_SB(1, 0), b3, voffB); PG8_STAGE(PG8_SB(1, 1), b3 + hstep, voffB); PG8_STAGE(PG8_SA(1, 0), a3, voffA);
            PG8_WAIT_V(8); PG8_WAIT_L(0); PG8_BAR; PG8_MMA(1, 0, At, B0); PG8_MMA(1, 1, At, B1); PG8_BAR; PG8_SCHED;
            } else {
            PG8_LDB(B0, 0, 0); PG8_SCHED; PG8_LDA(At, 0, 0); PG8_STAGE(PG8_SA(1, 1), a1 + hstep, voffA);
            PG8_WAIT_L(8); PG8_BAR; PG8_WAIT_L(0); PG8_MMA(0, 0, At, B0); PG8_BAR; PG8_SCHED;
            PG8_LDB(B1, 0, 1); PG8_STAGE(PG8_SB(0, 0), b2, voffB);
            PG8_BAR; PG8_WAIT_L(0); PG8_MMA(0, 1, At, B1); PG8_BAR;
            PG8_LDA(At, 0, 1); PG8_STAGE(PG8_SA(0, 0), a2, voffA);
            PG8_BAR; PG8_WAIT_L(0); PG8_MMA(1, 0, At, B0); PG8_BAR; PG8_SCHED;
            PG8_STAGE(PG8_SB(0, 1), b2 + hstep, voffB);
            PG8_WAIT_V(6); PG8_BAR; PG8_MMA(1, 1, At, B1); PG8_BAR;
            PG8_LDB(B0, 1, 0); PG8_SCHED; PG8_LDA(At, 1, 0); PG8_STAGE(PG8_SA(0, 1), a2 + hstep, voffA);
            PG8_WAIT_L(8); PG8_BAR; PG8_WAIT_L(0); PG8_MMA(0, 0, At, B0); PG8_BAR; PG8_SCHED;
            PG8_LDB(B1, 1, 1); PG8_STAGE(PG8_SB(1, 0), b3, voffB);
            PG8_BAR; PG8_WAIT_L(0); PG8_MMA(0, 1, At, B1); PG8_BAR;
            PG8_LDA(At, 1, 1); PG8_STAGE(PG8_SA(1, 0), a3, voffA);
            PG8_BAR; PG8_WAIT_L(0); PG8_MMA(1, 0, At, B0); PG8_BAR; PG8_SCHED;
            PG8_STAGE(PG8_SB(1, 1), b3 + hstep, voffB);
            PG8_WAIT_V(6); PG8_BAR; PG8_MMA(1, 1, At, B1); PG8_BAR;
            }
        }
        if constexpr (Epi::F8) asm volatile("s_nop 15\n\ts_nop 15" ::: "memory");
        if constexpr (ALIGN_EPI) { if (wr == 0) PG8_BAR; }
        if constexpr (!Epi::AFTER_DRAIN) { E(acc, cur, wr, wc, fr, fq); S.done(cur); }
        if (!has_next) break;
#pragma unroll
        for (int a = 0; a < 2; ++a)
#pragma unroll
            for (int b = 0; b < 2; ++b)
#pragma unroll
                for (int m = 0; m < 4; ++m)
#pragma unroll
                    for (int n = 0; n < 2; ++n) acc[a][b][m][n] = (f32x4){0.f, 0.f, 0.f, 0.f};
        cur = nxt; cA = nA; cB = nB; ++ui;
        if constexpr (ALIGN_EPI) { if (wr == 1) PG8_BAR; }
    }
    PG8_WAIT_V(0);
    if constexpr (!ALIGN_EPI) { if (wr == 0) PG8_BAR; }
    PG8_BAR;
    if constexpr (Epi::AFTER_DRAIN) { E.fused(acc, cur, wr, wc, fr, fq, lds, wid, lane); S.done(cur); }
#undef PG8_SA
#undef PG8_SB
#undef PG8_STAGE
#undef PG8_LDA
#undef PG8_LDB
#undef PG8_MMA
#undef PG8_WAIT_V
#undef PG8_WAIT_L
#undef PG8_BAR
#undef PG8_SCHED
}
#endif
}

namespace pg8 {
struct EpiStoreBf16 {
    static constexpr bool PERM = true, AFTER_DRAIN = false, F8 = false;
    bf16_t* O; int ldc; int ntn;
    __device__ __forceinline__ void operator()(const f32x4 (&acc)[2][2][4][2], const Unit& u, int wr, int wc, int fr, int fq) const {
        const int row0 = u.pm * BM + wr * 64 + fr, col0 = (u.pn % ntn) * BM + wc * 32 + 8 * fq;
#pragma unroll
        for (int ai = 0; ai < 2; ++ai)
#pragma unroll
            for (int m = 0; m < 4; ++m) { bf16_t* rowp = O + (size_t)(row0 + ai * HALF + m * 16) * ldc + col0;
#pragma unroll
                for (int bj = 0; bj < 2; ++bj) { const f32x4 v0 = acc[ai][bj][m][0], v1 = acc[ai][bj][m][1];
                    u32x4 w; w.x = pk2(v0[0], v0[1]); w.y = pk2(v0[2], v0[3]); w.z = pk2(v1[0], v1[1]); w.w = pk2(v1[2], v1[3]);
                    *(u32x4*)(rowp + bj * HALF) = w; } }
    }
};
struct EpiSwiglu {
    static constexpr bool PERM = true, AFTER_DRAIN = false, F8 = false;
    bf16_t* O; int ldc; int ntn;
    __device__ __forceinline__ void operator()(const f32x4 (&acc)[2][2][4][2], const Unit& u, int wr, int wc, int fr, int fq) const {
        const int row0 = u.pm * BM + wr * 64 + fr, col0 = (u.pn % ntn) * HALF + wc * 32 + 8 * fq;
#pragma unroll
        for (int ai = 0; ai < 2; ++ai)
#pragma unroll
            for (int m = 0; m < 4; ++m) { bf16_t* rowp = O + (size_t)(row0 + ai * HALF + m * 16) * ldc + col0;
                float hv[8];
#pragma unroll
                for (int n = 0; n < 2; ++n)
#pragma unroll
                    for (int q = 0; q < 4; ++q) { const float g = acc[ai][0][m][n][q], up = acc[ai][1][m][n][q]; hv[n * 4 + q] = silu_f(g) * up; }
                u32x4 w; w.x = pk2(hv[0], hv[1]); w.y = pk2(hv[2], hv[3]); w.z = pk2(hv[4], hv[5]); w.w = pk2(hv[6], hv[7]);
                *(u32x4*)rowp = w; }
    }
};
struct EpiStoreBf16S {
    static constexpr bool PERM = true, AFTER_DRAIN = false, F8 = true;
    bf16_t* O; int ldc; int ntn; float scl;
    __device__ __forceinline__ void operator()(const f32x4 (&acc)[2][2][4][2], const Unit& u, int wr, int wc, int fr, int fq) const {
        const int row0 = u.pm * BM + wr * 64 + fr, col0 = (u.pn % ntn) * BM + wc * 32 + 8 * fq;
#pragma unroll
        for (int ai = 0; ai < 2; ++ai)
#pragma unroll
            for (int m = 0; m < 4; ++m) { bf16_t* rowp = O + (size_t)(row0 + ai * HALF + m * 16) * ldc + col0;
#pragma unroll
                for (int bj = 0; bj < 2; ++bj) { const f32x4 v0 = acc[ai][bj][m][0] * scl, v1 = acc[ai][bj][m][1] * scl;
                    u32x4 w; w.x = pk2(v0[0], v0[1]); w.y = pk2(v0[2], v0[3]); w.z = pk2(v1[0], v1[1]); w.w = pk2(v1[2], v1[3]);
                    *(u32x4*)(rowp + bj * HALF) = w; } }
    }
};
struct EpiSwigluF8 {
    static constexpr bool PERM = true, AFTER_DRAIN = false, F8 = true;
    unsigned char* O; int ldc; int ntn; float scl;
    __device__ __forceinline__ void operator()(const f32x4 (&acc)[2][2][4][2], const Unit& u, int wr, int wc, int fr, int fq) const {
        const int row0 = u.pm * BM + wr * 64 + fr, col0 = (u.pn % ntn) * HALF + wc * 32 + 8 * fq;
#pragma unroll
        for (int ai = 0; ai < 2; ++ai)
#pragma unroll
            for (int m = 0; m < 4; ++m) { unsigned char* rowp = O + (size_t)(row0 + ai * HALF + m * 16) * ldc + col0;
                float hv[8];
#pragma unroll
                for (int n = 0; n < 2; ++n)
#pragma unroll
                    for (int q = 0; q < 4; ++q) { const float g = acc[ai][0][m][n][q] * scl, up = acc[ai][1][m][n][q] * (scl * F8_SM); hv[n * 4 + q] = silu_f(g) * up; }
                u32x2 w; w.x = pk4_f8(hv[0], hv[1], hv[2], hv[3]); w.y = pk4_f8(hv[4], hv[5], hv[6], hv[7]);
                *(u32x2*)rowp = w; }
    }
};
struct EpiResid {
    static constexpr bool PERM = false, AFTER_DRAIN = false, F8 = false;
    const float* Xin; float* Xout; const float* gate_lat; const float* gate_ctx;
    __device__ __forceinline__ void operator()(const f32x4 (&acc)[2][2][4][2], const Unit& u, int wr, int wc, int fr, int fq) const {
        const float* gp = (u.pm == 0) ? gate_ctx : gate_lat;
        const int row0 = u.pm * BM + wr * 64 + fr, col0 = u.pn * BM + wc * 32 + 4 * fq;
#pragma unroll
        for (int bj = 0; bj < 2; ++bj)
#pragma unroll
            for (int n = 0; n < 2; ++n) { const int col = col0 + bj * HALF + n * 16; const f32x4 gv = *(const f32x4*)(gp + col);
#pragma unroll
                for (int ai = 0; ai < 2; ++ai)
#pragma unroll
                    for (int m = 0; m < 4; ++m) { const size_t o = (size_t)(row0 + ai * HALF + m * 16) * D + col; *(f32x4*)(Xout + o) = *(const f32x4*)(Xin + o) + gv * acc[ai][bj][m][n]; } }
    }
};
struct EpiQkvRope {
    static constexpr bool PERM = true, AFTER_DRAIN = false, F8 = false;
    bf16_t* QR; bf16_t* KR; bf16_t* P; const float* tab; unsigned* kb;
    __device__ __forceinline__ void operator()(const f32x4 (&acc)[2][2][4][2], const Unit& u, int wr, int wc, int fr, int fq) const {
        const int row0 = u.pm * BM + wr * 64 + fr, lane = fq * 16 + fr;
        if (u.pn >= 8) {
            const int col0 = u.pn * BM + wc * 32 + 8 * fq;
#pragma unroll
            for (int ai = 0; ai < 2; ++ai)
#pragma unroll
                for (int m = 0; m < 4; ++m) { bf16_t* rowp = P + (size_t)(row0 + ai * HALF + m * 16) * DQKV + col0;
#pragma unroll
                    for (int bj = 0; bj < 2; ++bj) { const f32x4 v0 = acc[ai][bj][m][0], v1 = acc[ai][bj][m][1];
                        u32x4 w; w.x = pk2(v0[0], v0[1]); w.y = pk2(v0[2], v0[3]); w.z = pk2(v1[0], v1[1]); w.w = pk2(v1[2], v1[3]);
                        *(u32x4*)(rowp + bj * HALF) = w; } }
            return;
        }
        const bool isq = u.pn < 4; bf16_t* dst = isq ? QR : KR; const float scl = isq ? QSCALE : 1.0f;
        const int axis = wc & 1, i0 = 8 * (fq & 1); const float sgn = (fq & 2) ? 1.0f : -1.0f;
        float kmx[2] = {0.f, 0.f};
#pragma unroll
        for (int ai = 0; ai < 2; ++ai)
#pragma unroll
            for (int m = 0; m < 4; ++m) { const int row = row0 + ai * HALF + m * 16; const int pa = axis ? (row % GRID_W) : (row / GRID_W);
                const f32x4* tp = (const f32x4*)(tab + (size_t)(pa * 16 + i0) * 2); const f32x4 t0 = tp[0], t1 = tp[1], t2 = tp[2], t3 = tp[3];
                const float cs[8] = {t0[0], t0[2], t1[0], t1[2], t2[0], t2[2], t3[0], t3[2]}, sn[8] = {t0[1], t0[3], t1[1], t1[3], t2[1], t2[3], t3[1], t3[3]};
#pragma unroll
                for (int bj = 0; bj < 2; ++bj) { float o[8]; float ssq = 0.f;
#pragma unroll
                    for (int k = 0; k < 8; ++k) { const float own = acc[ai][bj][m][k >> 2][k & 3]; const float par = PARTNER32(own, lane); o[k] = (own * cs[k] + sgn * par * sn[k]) * scl; }
                    u32x4 w; w.x = pk2(o[0], o[1]); w.y = pk2(o[2], o[3]); w.z = pk2(o[4], o[5]); w.w = pk2(o[6], o[7]);
                    *(u32x4*)(dst + (size_t)(CTX + row) * D + (u.pn & 3) * BM + bj * HALF + wc * 32 + 8 * fq) = w;
                    if (!isq) {
#pragma unroll
                        for (int e = 0; e < 4; ++e) ssq += bflo(w[e]) * bflo(w[e]) + bfhi(w[e]) * bfhi(w[e]);
                        kmx[bj] = fmaxf(kmx[bj], ssq); } } }
        if (!isq) {
#pragma unroll
            for (int bj = 0; bj < 2; ++bj) { float v = kmx[bj];
#pragma unroll
                for (int o2 = 1; o2 < 16; o2 <<= 1) v = fmaxf(v, SHX(v, o2, lane));
                const int head = (u.pn & 3) * 2 + bj, map = wc >> 1, part = (wc & 1) * 4 + fq;
                if (fr == 0) atomicMax(kb + (head * 2 + map) * 8 + part, __builtin_bit_cast(unsigned, v)); }
        }
    }
};
struct MoeOrder {
    const int* tab; int ntn, G, c;
    __device__ __forceinline__ bool next(int i, Unit& u) const {
        const int ntr = tab[0]; const long L = (long)i * G + c; if (L >= (long)ntr * ntn) return false;
        const int rt = (int)(L / ntn), ct = (int)(L % ntn); u.pm = rt; u.pn = tab[16 + rt] * ntn + ct; return true;
    }
    __device__ __forceinline__ void a_ready(const Unit&) const {}
    __device__ __forceinline__ void done(const Unit&) const {}
};
}

#ifndef CPU_SIM
#define XB_TMO      128
#define XB_XCNT(j)  (256  + 64 * (j))
#define XB_XSUB(j)  (1280 + 64 * (j))
#define XB_XGEN(j)  (2304 + 64 * (j))
#define XB_TOP      3328
#define XB_TOPGEN   3392
#define XCD_BAR_WORDS 3456
#define XB_SPIN_CAP (1u << 18)
__device__ __forceinline__ unsigned xb_ld(unsigned* p)              { return __hip_atomic_load(p, __ATOMIC_RELAXED, __HIP_MEMORY_SCOPE_AGENT); }
__device__ __forceinline__ unsigned xb_add(unsigned* p, unsigned v) { return __hip_atomic_fetch_add(p, v, __ATOMIC_RELAXED, __HIP_MEMORY_SCOPE_AGENT); }
__device__ __forceinline__ unsigned xb_xcc_id() { return (unsigned)__builtin_amdgcn_s_getreg((3 << 11) | 20) & 0xFu; }
#define XB_SPIN(cond, bar) do { unsigned _sp = 0; while (cond) { __builtin_amdgcn_s_sleep(1); \
    if ((++_sp & 255u) == 0u) { if (xb_ld(&(bar)[XB_TMO])) break; if (_sp > XB_SPIN_CAP) { atomicAdd(&(bar)[XB_TMO], 1u); break; } } } } while (0)
struct XcdBarrier { unsigned* bar; unsigned x; volatile LAS unsigned* st; };
__device__ __forceinline__ XcdBarrier xcd_barrier_post(unsigned* bar, volatile LAS unsigned* st, int tid) {
    XcdBarrier b; b.bar = bar; b.x = xb_xcc_id(); b.st = st;
    if (tid == 0) (void)xb_add(&bar[XB_XCNT(b.x)], 1u);
    return b;
}
__device__ __forceinline__ void xcd_barrier_complete(unsigned* bar, unsigned x, unsigned& nloc, unsigned& nx) {
    const unsigned G = gridDim.x * gridDim.y * gridDim.z;
    unsigned sum, cnt, mine, sp = 0u;
    for (;;) {
        sum = 0u; cnt = 0u; mine = 0u;
#pragma unroll
        for (unsigned j = 0; j < 16; ++j) { const unsigned c = xb_ld(&bar[XB_XCNT(j)]); sum += c; cnt += (c > 0u) ? 1u : 0u; mine = (j == x) ? c : mine; }
        if (sum == G) break;
        __builtin_amdgcn_s_sleep(1);
        if ((++sp & 255u) == 0u) { if (xb_ld(&bar[XB_TMO])) break; if (sp > XB_SPIN_CAP) { atomicAdd(&bar[XB_TMO], 1u); break; } }
    }
    nloc = mine > 0u ? mine : 1u; nx = cnt > 0u ? cnt : 1u;
}
__device__ __forceinline__ void xcd_barrier(const XcdBarrier& b, int tid) {
    asm volatile("s_waitcnt vmcnt(0)" ::: "memory");
    __syncthreads();
    if (tid == 0) {
        unsigned* bar = b.bar;
        __builtin_amdgcn_s_waitcnt(0);
        unsigned nloc = b.st[0], nx = b.st[1];
        if (nloc == 0u) { xcd_barrier_complete(bar, b.x, nloc, nx); b.st[0] = nloc; b.st[1] = nx; }
        const unsigned old = xb_add(&bar[XB_XSUB(b.x)], 1u);
        const unsigned gen = old / nloc;
        if (old + 1u == (gen + 1u) * nloc) {
            __builtin_amdgcn_fence(__ATOMIC_RELEASE, "agent");
            asm volatile("s_waitcnt vmcnt(0)" ::: "memory");
            const unsigned og = xb_add(&bar[XB_TOP], 1u);
            const unsigned tg = og / nx;
            if (og + 1u == (tg + 1u) * nx) xb_add(&bar[XB_TOPGEN], 1u);
            else XB_SPIN(xb_ld(&bar[XB_TOPGEN]) == tg, bar);
            __builtin_amdgcn_fence(__ATOMIC_ACQUIRE, "agent");
            xb_add(&bar[XB_XGEN(b.x)], 1u);
            asm volatile("s_waitcnt vmcnt(0)" ::: "memory");
        } else {
            XB_SPIN(xb_ld(&bar[XB_XGEN(b.x)]) == gen, bar);
            __builtin_amdgcn_fence(__ATOMIC_ACQUIRE, "agent");
            asm volatile("s_waitcnt vmcnt(0)" ::: "memory");
        }
    }
    __syncthreads();
}
#endif

struct KArgs { const float* in[26]; float* out; unsigned char* ws; int ph_lo, ph_hi; int variant; };
#ifdef CPU_SIM
typedef const KArgs* KArgP;
#define TIDX(a) ((a).tid)
#define FRESH_TID(a) ((int)threadIdx.x)
#else
typedef const __attribute__((address_space(4))) KArgs* KArgP;
#define TIDX(a) ((a).tid)
#define FRESH_TID(a) ({ unsigned z_ = 0u; asm volatile("" : "+s"(z_)); (a).wv * 64 + (int)__builtin_amdgcn_mbcnt_hi(~0u, __builtin_amdgcn_mbcnt_lo(~0u, z_)); })
#endif
struct KCtx { KArgP p; int wv, tid, bx, G; LAS unsigned char* L; };
enum { I_X = 0, I_C, I_CTX, I_CCTX, I_MODW, I_MODB, I_HGLB, I_EVWIN, I_HGNG, I_SGLNG, I_SGLNB, I_SGW, I_SGB, I_EVWOUT, I_DAQKV, I_DALAM, I_DASUBG, I_DAWOUT,
       I_FFG, I_FFU, I_FFD, I_MOER, I_MOEG, I_MOEU, I_MOED, I_FING };

#define WSP(T_, off) ((T_*)(a.p->ws + (off)))

__device__ __forceinline__ void tr_item(const float* W, int N, int K, bf16_t* WT, int k0, int n0, int drow0, LAS float* scr, int lane) {
    float wv[64];
#pragma unroll
    for (int kk = 0; kk < 64; ++kk) wv[kk] = W[(size_t)(k0 + kk) * N + n0 + lane];
#pragma unroll
    for (int kk = 0; kk < 64; ++kk) scr[kk * 65 + lane] = wv[kk];
    WAVE_SYNC();
    const int c = lane & 7;
#pragma unroll
    for (int j = 0; j < 8; ++j) { const int n = (lane >> 3) + 8 * j; const LAS float* s = scr + (8 * c) * 65 + n;
        u32x4 o; o.x = pk2(s[0 * 65], s[1 * 65]); o.y = pk2(s[2 * 65], s[3 * 65]); o.z = pk2(s[4 * 65], s[5 * 65]); o.w = pk2(s[6 * 65], s[7 * 65]);
        *(u32x4*)(WT + (size_t)(drow0 + n) * K + k0 + 8 * c) = o; }
    WAVE_SYNC();
}
__device__ __forceinline__ void tr_item8(const float* W, int N, int K, unsigned char* WT, int k0, int n0, int drow0, LAS float* scr, int lane) {
    float wv[64];
#pragma unroll
    for (int kk = 0; kk < 64; ++kk) wv[kk] = W[(size_t)(k0 + kk) * N + n0 + lane];
#pragma unroll
    for (int kk = 0; kk < 64; ++kk) scr[kk * 65 + lane] = wv[kk];
    WAVE_SYNC();
    const int c = lane & 3;
#pragma unroll
    for (int j = 0; j < 4; ++j) { const int n = (lane >> 2) + 16 * j; const LAS float* s = scr + (16 * c) * 65 + n;
        u32x4 o; o.x = pk4_f8(s[0 * 65] * F8_SW, s[1 * 65] * F8_SW, s[2 * 65] * F8_SW, s[3 * 65] * F8_SW); o.y = pk4_f8(s[4 * 65] * F8_SW, s[5 * 65] * F8_SW, s[6 * 65] * F8_SW, s[7 * 65] * F8_SW);
        o.z = pk4_f8(s[8 * 65] * F8_SW, s[9 * 65] * F8_SW, s[10 * 65] * F8_SW, s[11 * 65] * F8_SW); o.w = pk4_f8(s[12 * 65] * F8_SW, s[13 * 65] * F8_SW, s[14 * 65] * F8_SW, s[15 * 65] * F8_SW);
        *(u32x4*)(WT + (size_t)(drow0 + n) * K + k0 + 16 * c) = o; }
    WAVE_SYNC();
}
template <int MODE, bool F8 = false>
__device__ __forceinline__ void tr_mat(const float* W, int K, int N, bf16_t* WT, LAS float* scr, int gw, int NGW, int lane, int& itbase) {
    const int nblk = N / 64, nitems = (K / 64) * nblk;
    for (int it = ((gw - itbase) % NGW + NGW) % NGW; it < nitems; it += NGW) {
        const int kb = it / nblk, nb = it % nblk, n0 = nb * 64;
        const int drow0 = MODE == 0 ? n0 : ((n0 >> 7) * 256 + (n0 & 127) + (MODE == 2 ? 128 : 0));
        if (F8) tr_item8(W, N, K, (unsigned char*)WT, kb * 64, n0, drow0, scr, lane); else tr_item(W, N, K, WT, kb * 64, n0, drow0, scr, lane);
    }
    itbase = (itbase + nitems) % NGW;
}
__device__ __forceinline__ void moe_weights(const KCtx& a, int j, LAS unsigned char* lds, int& itbase) {
    const int tid = TIDX(a), lane = tid & 63, wave = rfl(tid >> 6), gw = a.bx * NWAVES + wave, NGW = a.G * NWAVES;
    LAS float* scr = (LAS float*)(lds + wave * 16896);
    for (int e = 0; e < NEXP; ++e) {
        bf16_t* gu = (bf16_t*)(WSP(unsigned char, WS_MGU) + (size_t)e * 2 * EFF * D); bf16_t* dn = (bf16_t*)(WSP(unsigned char, WS_MDN) + (size_t)e * D * EFF);
        tr_mat<1, true>(a.p->in[I_MOEG] + (size_t)(j * NEXP + e) * D * EFF, D, EFF, gu, scr, gw, NGW, lane, itbase);
        tr_mat<2, true>(a.p->in[I_MOEU] + (size_t)(j * NEXP + e) * D * EFF, D, EFF, gu, scr, gw, NGW, lane, itbase);
        tr_mat<0, true>(a.p->in[I_MOED] + (size_t)(j * NEXP + e) * EFF * D, EFF, D, dn, scr, gw, NGW, lane, itbase);
    }
}
__device__ __forceinline__ void ph_prologue(const KCtx& a, LAS unsigned char* lds) {
    const int tid = TIDX(a), lane = tid & 63, wave = rfl(tid >> 6), gw = a.bx * NWAVES + wave, NGW = a.G * NWAVES;
    LAS float* sv = (LAS float*)lds;
    for (int i = tid; i < 2048; i += NTHR) sv[i] = silu_f(i < 1024 ? a.p->in[I_C][i] : a.p->in[I_CCTX][i - 1024]);
    __syncthreads();
    float* modv = WSP(float, WS_SMALL + SM_MODV);
    LAS float* part = (LAS float*)(lds + 8192);
    for (int it = a.bx; it < 4 * 96; it += a.G) {
        const int l = it / 96, n = (it % 96) * 64 + lane; const float* W = a.p->in[I_MODW] + (size_t)l * D * 6144 + (size_t)(wave * 128) * 6144 + n; float a0 = 0.f, a1 = 0.f;
#pragma unroll 16
        for (int k = 0; k < 128; ++k) { const float w = W[(size_t)k * 6144]; a0 += sv[wave * 128 + k] * w; a1 += sv[1024 + wave * 128 + k] * w; }
        part[(wave * 2 + 0) * 64 + lane] = a0; part[(wave * 2 + 1) * 64 + lane] = a1;
        __syncthreads();
        if (wave < 2) { float sacc = 0.f;
#pragma unroll
            for (int w = 0; w < 8; ++w) sacc += part[(w * 2 + wave) * 64 + lane];
            modv[(l * 2 + wave) * 6144 + n] = sacc + a.p->in[I_MODB][l * 6144 + n]; }
        __syncthreads();
    }
    __syncthreads();
    { const int gt0 = a.bx * NTHR + tid; if (gt0 < 256 * 16) { const int pos = gt0 >> 4, i = gt0 & 15; const float ang = (float)pos * expf(-(float)(2 * i) * (1.0f / 32.0f) * 9.210340371976184f);
        float* tb = WSP(float, WS_SMALL + SM_ROPE) + gt0 * 2; tb[0] = cosf(ang); tb[1] = sinf(ang); } }
    if (a.bx == 0 && wave < 2) {
        const float* lm = a.p->in[I_DALAM] + wave * 256; const float s1 = wave_sum(lm[lane] * lm[64 + lane], lane), s2 = wave_sum(lm[128 + lane] * lm[192 + lane], lane);
        const float lam_init = 0.8f - 0.6f * expf(-0.3f * (float)(2 * wave + 1));
        if (lane == 0) WSP(float, WS_SMALL + SM_LAMF)[wave] = expf(s1) - expf(s2) + lam_init;
    }
    { const int gt = a.bx * NTHR + tid, NGT = a.G * NTHR;
      bf16_t* sgw = WSP(bf16_t, WS_SGW);
      for (int i = gt; i < 2 * 4 * 128 * 128; i += NGT) sgw[i] = (bf16_t)f2bf(a.p->in[I_SGW][i]); }
    LAS float* scr = (LAS float*)(lds + wave * 16896);
    int itbase = 0;
    for (int j = 0; j < 2; ++j) {
        tr_mat<0>(a.p->in[I_EVWIN] + (size_t)j * D * EVEN_IN, D, EVEN_IN, WSP(bf16_t, WS_WIN + j * SZ_WIN), scr, gw, NGW, lane, itbase);
        tr_mat<0>(a.p->in[I_EVWOUT] + (size_t)j * D * D, D, D, WSP(bf16_t, WS_WEO + j * SZ_WSQ), scr, gw, NGW, lane, itbase);
        tr_mat<1>(a.p->in[I_FFG] + (size_t)j * D * DFF, D, DFF, WSP(bf16_t, WS_WGU + j * SZ_WGU), scr, gw, NGW, lane, itbase);
        tr_mat<2>(a.p->in[I_FFU] + (size_t)j * D * DFF, D, DFF, WSP(bf16_t, WS_WGU + j * SZ_WGU), scr, gw, NGW, lane, itbase);
        tr_mat<0>(a.p->in[I_FFD] + (size_t)j * DFF * D, DFF, D, WSP(bf16_t, WS_WDN + j * SZ_WDN), scr, gw, NGW, lane, itbase);
        tr_mat<0>(a.p->in[I_DAQKV] + (size_t)j * D * DQKV, D, DQKV, WSP(bf16_t, WS_WQKV + j * SZ_WQKV), scr, gw, NGW, lane, itbase);
        tr_mat<0>(a.p->in[I_DAWOUT] + (size_t)j * D * D, D, D, WSP(bf16_t, WS_WAO + j * SZ_WSQ), scr, gw, NGW, lane, itbase);
    }
    moe_weights(a, 0, lds, itbase);
}

template <bool COMBINE, bool ROUTER, bool FINAL, bool FROMIN = false>
__device__ __forceinline__ void ph_rowpass(const KCtx& a, int layer, int which) {
    const int tid = TIDX(a), lane = tid & 63, wave = rfl(tid >> 6), gw = a.bx * NWAVES + wave, NGW = a.G * NWAVES;
    const float* X = (COMBINE || which == 1) ? WSP(float, WS_X1) : WSP(float, WS_X); float* XW = WSP(float, WS_X);
    const float* XC = a.p->in[I_CTX]; const float* XL = a.p->in[I_X] - (size_t)CTX * D;
#define ROWP(r) (FROMIN ? (((r) < CTX ? XC : XL) + (size_t)(r) * D) : (X + (size_t)(r) * D))
    bf16_t* H = WSP(bf16_t, WS_H); const float* modv = WSP(float, WS_SMALL + SM_MODV);
    const int* tok_pos = WSP(int, WS_TOK + (size_t)T * 16); const float* tok_w = WSP(float, WS_TOK + (size_t)T * 8);
    f32x4 vn[4];
    { const int r0 = gw < T ? gw : 0;
#pragma unroll
      for (int j = 0; j < 4; ++j) vn[j] = *(const f32x4*)(ROWP(r0) + 4 * lane + 256 * j); }
    int tp0 = 0, tp1 = 0, tw0 = 0, tw1 = 0; u32x2 yn0[4], yn1[4];
    if (COMBINE) {
        const int rr = gw + lane * NGW;
        if (rr < T) { tp0 = tok_pos[rr * 2]; tp1 = tok_pos[rr * 2 + 1]; tw0 = __builtin_bit_cast(int, tok_w[rr * 2]); tw1 = __builtin_bit_cast(int, tok_w[rr * 2 + 1]); }
        const bf16_t* y0 = WSP(bf16_t, WS_Y) + (size_t)SHI(tp0, 0, lane) * D; const bf16_t* y1 = WSP(bf16_t, WS_Y) + (size_t)SHI(tp1, 0, lane) * D;
#pragma unroll
        for (int j = 0; j < 4; ++j) { yn0[j] = *(const u32x2*)(y0 + 4 * lane + 256 * j); yn1[j] = *(const u32x2*)(y1 + 4 * lane + 256 * j); }
    }
    int it = 0;
    for (int row = gw; row < T; row += NGW, ++it) {
        const int s = row < CTX ? 1 : 0;
        f32x4 v[4];
#pragma unroll
        for (int j = 0; j < 4; ++j) v[j] = vn[j];
        { const int rn = row + NGW < T ? row + NGW : row;
#pragma unroll
          for (int j = 0; j < 4; ++j) vn[j] = *(const f32x4*)(ROWP(rn) + 4 * lane + 256 * j); }
        u32x2 yc0[4], yc1[4]; float w0 = 0.f, w1 = 0.f;
        if (COMBINE) {
#pragma unroll
            for (int j = 0; j < 4; ++j) { yc0[j] = yn0[j]; yc1[j] = yn1[j]; }
            w0 = __builtin_bit_cast(float, SHI(tw0, it, lane)); w1 = __builtin_bit_cast(float, SHI(tw1, it, lane));
            const bf16_t* y0 = WSP(bf16_t, WS_Y) + (size_t)SHI(tp0, it + 1, lane) * D; const bf16_t* y1 = WSP(bf16_t, WS_Y) + (size_t)SHI(tp1, it + 1, lane) * D;
#pragma unroll
            for (int j = 0; j < 4; ++j) { yn0[j] = *(const u32x2*)(y0 + 4 * lane + 256 * j); yn1[j] = *(const u32x2*)(y1 + 4 * lane + 256 * j); }
        }
        if (FINAL && row < CTX) continue;
        if (COMBINE) {
            const int lp = FINAL ? 3 : layer - 1; const float* g2 = modv + ((lp * 2 + s) * 6 + 5) * 1024;
#pragma unroll
            for (int j = 0; j < 4; ++j) { const int col = 4 * lane + 256 * j; const u32x2 r0 = yc0[j], r1 = yc1[j]; const f32x4 g = *(const f32x4*)(g2 + col);
                v[j][0] += g[0] * (w0 * bflo(r0.x) + w1 * bflo(r1.x)); v[j][1] += g[1] * (w0 * bfhi(r0.x) + w1 * bfhi(r1.x));
                v[j][2] += g[2] * (w0 * bflo(r0.y) + w1 * bflo(r1.y)); v[j][3] += g[3] * (w0 * bfhi(r0.y) + w1 * bfhi(r1.y));
                if (!FINAL) *(f32x4*)(XW + (size_t)row * D + col) = v[j]; }
        }
        float ss = 0.f;
#pragma unroll
        for (int j = 0; j < 4; ++j) ss += (v[j][0] * v[j][0] + v[j][1] * v[j][1]) + (v[j][2] * v[j][2] + v[j][3] * v[j][3]);
        ss = wave_sum(ss, lane); const float r = 1.0f / sqrtf(ss * (1.0f / D) + 1e-6f);
        if (FINAL) {
            float* o = a.p->out + (size_t)(row - CTX) * D;
#pragma unroll
            for (int j = 0; j < 4; ++j) { const int col = 4 * lane + 256 * j; const f32x4 g = *(const f32x4*)(a.p->in[I_FING] + col); *(f32x4*)(o + col) = v[j] * r * g; }
            continue;
        }
        const float* mv = modv + ((layer * 2 + s) * 6 + which * 3) * 1024;
        float lg[8];
#pragma unroll
        for (int e = 0; e < 8; ++e) lg[e] = 0.f;
#pragma unroll
        for (int j = 0; j < 4; ++j) { const int col = 4 * lane + 256 * j; const f32x4 sh = *(const f32x4*)(mv + col), sc = *(const f32x4*)(mv + 1024 + col);
            const f32x4 y = v[j] * r * (sc + 1.0f) + sh;
            if (ROUTER) { *(unsigned*)((unsigned char*)H + (size_t)row * D + col) = pk4_f8(y[0] * F8_SH, y[1] * F8_SH, y[2] * F8_SH, y[3] * F8_SH); }
            else { u32x2 w; w.x = pk2(y[0], y[1]); w.y = pk2(y[2], y[3]); *(u32x2*)(H + (size_t)row * D + col) = w; }
            if (ROUTER) { const float* wr = a.p->in[I_MOER] + (size_t)(layer >> 1) * D * NEXP + (size_t)col * NEXP;
#pragma unroll
                for (int q = 0; q < 4; ++q) { const f32x4 wa = *(const f32x4*)(wr + q * 8), wb = *(const f32x4*)(wr + q * 8 + 4);
                    lg[0] += y[q] * wa[0]; lg[1] += y[q] * wa[1]; lg[2] += y[q] * wa[2]; lg[3] += y[q] * wa[3]; lg[4] += y[q] * wb[0]; lg[5] += y[q] * wb[1]; lg[6] += y[q] * wb[2]; lg[7] += y[q] * wb[3]; } }
        }
        if (ROUTER) {
            { float r4[4], r2[2], r1; const bool u5 = (lane & 32) != 0, u4 = (lane & 16) != 0, u3 = (lane & 8) != 0;
#pragma unroll
              for (int q = 0; q < 4; ++q) { const float mine = u5 ? lg[4 + q] : lg[q], send = u5 ? lg[q] : lg[4 + q]; r4[q] = mine + SHX(send, 32, lane); }
#pragma unroll
              for (int q = 0; q < 2; ++q) { const float mine = u4 ? r4[2 + q] : r4[q], send = u4 ? r4[q] : r4[2 + q]; r2[q] = mine + SHX(send, 16, lane); }
              { const float mine = u3 ? r2[1] : r2[0], send = u3 ? r2[0] : r2[1]; r1 = mine + SHX(send, 8, lane); }
              r1 += SHX(r1, 4, lane); r1 += SHX(r1, 2, lane); r1 += SHX(r1, 1, lane);
#pragma unroll
              for (int e = 0; e < 8; ++e) lg[e] = SHC(r1, 32 * (e >> 2) + 16 * ((e >> 1) & 1) + 8 * (e & 1)); }
            int e0 = 0; float b0 = lg[0];
#pragma unroll
            for (int e = 1; e < 8; ++e) if (lg[e] > b0) { b0 = lg[e]; e0 = e; }
            int e1 = -1; float b1 = -3.0e38f;
#pragma unroll
            for (int e = 0; e < 8; ++e) if (e != e0 && lg[e] > b1) { b1 = lg[e]; e1 = e; }
            if (lane == 0) { const float w0 = 1.0f / (1.0f + expf(b1 - b0));
                int* te = WSP(int, WS_TOK); float* tw = WSP(float, WS_TOK + (size_t)T * 8);
                te[row * 2] = e0; te[row * 2 + 1] = e1; tw[row * 2] = w0; tw[row * 2 + 1] = 1.0f - w0;
                unsigned* cnt = WSP(unsigned, WS_CTL) + CW_MOECNT + (layer >> 1) * 64;
                atomicAdd(cnt + e0, 1u); atomicAdd(cnt + e1, 1u); }
        }
    }
}

#undef ROWP
template <int MODE>
__device__ __forceinline__ void ctx_gemm(const KCtx& a, const bf16_t* A, const bf16_t* Bt, int K, int NC, bf16_t* O, int ldc, const float* Xin, float* Xout, const float* gate, LAS unsigned char* lds) {
    const int tid = TIDX(a), lane = tid & 63, wave = rfl(tid >> 6), fr = lane & 15, fq = lane >> 4, slot = wave >> 2, ks = wave & 3;
    const int nitems = 16 * (NC / 32), nb = K / 128;
    LAS f32x4* red = (LAS f32x4*)lds;
    __syncthreads();
    for (int base = a.bx * 2; base < nitems; base += a.G * 2) {
        const int it = base + slot; const bool valid = it < nitems; const int itc = valid ? it : 0;
        const int r0 = (itc & 15) * 16, c0 = (itc >> 4) * 32;
        const int wslot = 8 * (fr >> 2) + (fr & 3);
        const bf16_t* xp = A + (size_t)(r0 + fr) * K + 8 * fq;
        const bf16_t* wp = Bt + (size_t)(c0 + wslot) * K + 8 * fq;
        f32x4 acc[2];
        acc[0] = (f32x4){0.f, 0.f, 0.f, 0.f}; acc[1] = acc[0];
        bf16x8 xa[4], wa[4][2], xb[4], wb[4][2];
#define CTX_LOAD(xf, wf, kk) do { _Pragma("unroll") for (int s = 0; s < 4; ++s) { xf[s] = *(const bf16x8*)(xp + (kk) + 32 * s); \
            wf[s][0] = *(const bf16x8*)(wp + (kk) + 32 * s); wf[s][1] = *(const bf16x8*)(wp + (size_t)4 * K + (kk) + 32 * s); } } while (0)
#define CTX_MMA(xf, wf) do { _Pragma("unroll") for (int s = 0; s < 4; ++s) { acc[0] = mfma16(wf[s][0], xf[s], acc[0]); acc[1] = mfma16(wf[s][1], xf[s], acc[1]); } } while (0)
        if (ks < nb) CTX_LOAD(xa, wa, ks * 128);
        for (int b = ks; b < nb; b += 8) {
            if (b + 4 < nb) CTX_LOAD(xb, wb, (b + 4) * 128);
            CTX_MMA(xa, wa);
            if (b + 8 < nb) CTX_LOAD(xa, wa, (b + 8) * 128);
            if (b + 4 < nb) CTX_MMA(xb, wb);
        }
#undef CTX_LOAD
#undef CTX_MMA
        if (ks != 0) { red[((slot * 4 + ks) * 2 + 0) * 64 + lane] = acc[0]; red[((slot * 4 + ks) * 2 + 1) * 64 + lane] = acc[1]; }
        __syncthreads();
        if (ks == 0 && valid) {
#pragma unroll
            for (int k2 = 1; k2 < 4; ++k2) { acc[0] = acc[0] + red[((slot * 4 + k2) * 2 + 0) * 64 + lane]; acc[1] = acc[1] + red[((slot * 4 + k2) * 2 + 1) * 64 + lane]; }
            const int row = r0 + fr, col = c0 + 8 * fq;
            if (MODE == 0) { u32x4 w; w.x = pk2(acc[0][0], acc[0][1]); w.y = pk2(acc[0][2], acc[0][3]); w.z = pk2(acc[1][0], acc[1][1]); w.w = pk2(acc[1][2], acc[1][3]); *(u32x4*)(O + (size_t)row * ldc + col) = w; }
            else if (MODE == 3) {
                const float sc = col < 1024 ? QSCALE : 1.0f;
                u32x4 w; w.x = pk2(acc[0][0] * sc, acc[0][1] * sc); w.y = pk2(acc[0][2] * sc, acc[0][3] * sc); w.z = pk2(acc[1][0] * sc, acc[1][1] * sc); w.w = pk2(acc[1][2] * sc, acc[1][3] * sc);
                if (col < 1024) *(u32x4*)((bf16_t*)Xout + (size_t)row * D + col) = w;
                else if (col < 2048) { *(u32x4*)((bf16_t*)gate + (size_t)row * D + col - 1024) = w; float ssq = 0.f;
#pragma unroll
                    for (int e = 0; e < 4; ++e) ssq += bflo(w[e]) * bflo(w[e]) + bfhi(w[e]) * bfhi(w[e]);
#pragma unroll
                    for (int o2 = 1; o2 < 16; o2 <<= 1) ssq = fmaxf(ssq, SHX(ssq, o2, lane));
                    const int cc = col - 1024; if (fr == 0) atomicMax((unsigned*)Xin + ((cc >> 7) * 2 + ((cc >> 6) & 1)) * 8 + ((cc & 63) >> 3), __builtin_bit_cast(unsigned, ssq)); }
                else *(u32x4*)(O + (size_t)row * ldc + col) = w;
            }
            else { const size_t o = (size_t)row * D + col;
                *(f32x4*)(Xout + o) = *(const f32x4*)(Xin + o) + *(const f32x4*)(gate + col) * acc[0]; *(f32x4*)(Xout + o + 4) = *(const f32x4*)(Xin + o + 4) + *(const f32x4*)(gate + col + 4) * acc[1]; }
        }
        __syncthreads();
    }
}

__device__ __forceinline__ bf16x8 trfrag(const LAS unsigned char* base, int pitchB, int k0, int c0, int lane) {
    const int g = lane >> 4, q = (lane & 15) >> 2, p = lane & 3;
    const LAS unsigned char* a0 = base + (k0 + 8 * g + q) * pitchB + (c0 + 4 * p) * 2;
    const s16x4 lo = ds_tr16(a0), hi = ds_tr16(a0 + 4 * pitchB);
    return (bf16x8){lo[0], lo[1], lo[2], lo[3], hi[0], hi[1], hi[2], hi[3]};
}
__device__ __forceinline__ bf16x8 rowfrag(const LAS unsigned char* base, int pitchB, int r0, int k0, int lane) {
    return *(const LAS bf16x8*)(base + (r0 + (lane & 15)) * pitchB + (k0 + 8 * (lane >> 4)) * 2);
}

constexpr int HG_CUM = 0, HG_KT = 32768, HG_VV = 50176, HG_QS = 67584, HG_QT = 84992, HG_SS = 102400, HG_PT = 137216, HG_LBV = 139264, HP = 272  ;
constexpr int P_EVQ = 0, P_EVFF = 512, P_EVI = 1536, P_EVG = 2048, P_EVU = 2560, P_EVV = 3072;

__device__ __forceinline__ void hg_gates_from(const KCtx& a, int j, int h, int dir, const u32x4 (&raw)[2], LAS unsigned char* lds) {
    const int tid = TIDX(a);
    LAS float* lbv = (LAS float*)(lds + HG_LBV); LAS float* CUM = (LAS float*)(lds + HG_CUM);
    if (tid < 128) { const float* lb = a.p->in[I_HGLB] + (size_t)dir * 2 * 512 + h * 128 + tid; lbv[tid] = (j == 0) ? 0.f : 1.0f / (1.0f + expf(lb[0] - lb[512])); }
    __syncthreads();
#pragma unroll
    for (int i = 0; i < 2; ++i) { const int p = tid + NTHR * i, row = p >> 4, c8 = (p & 15) * 8;
        *(LAS u32x4*)(lds + HG_KT + row * HP + c8 * 2) = raw[i];
#pragma unroll
        for (int e = 0; e < 8; ++e) { const unsigned w = raw[i][e >> 1]; const float f = (e & 1) ? bfhi(w) : bflo(w); const float lb = lbv[c8 + e];
            float lf = __logf(lb + (1.0f - lb) * sigm_f(f)); lf = fmaxf(lf, -30.0f); CUM[row * 128 + c8 + e] = lf; } }
}
__device__ __forceinline__ void hg_load_gates(const KCtx& a, int j, int c, int h, int dir, LAS unsigned char* lds) {
    const int tid = TIDX(a); const bf16_t* proj = WSP(bf16_t, WS_PROJ); u32x4 raw[2];
#pragma unroll
    for (int i = 0; i < 2; ++i) { const int p = tid + NTHR * i, row = p >> 4, c8 = (p & 15) * 8; raw[i] = *(const u32x4*)(proj + (size_t)(c * HCH + row) * EVEN_IN + P_EVFF + dir * 512 + h * 128 + c8); }
    hg_gates_from(a, j, h, dir, raw, lds);
}
__device__ __forceinline__ float hg_cumsum(const KCtx& a, int dir, LAS unsigned char* lds) {
    const int tid = TIDX(a), ch = tid & 127, part = tid >> 7;
    LAS float* CUM = (LAS float*)(lds + HG_CUM); LAS float* PT = (LAS float*)(lds + HG_PT);
    float run = 0.f;
    for (int i = 0; i < 16; ++i) { const int r = part * 16 + i, t = dir ? 63 - r : r; run += CUM[t * 128 + ch]; CUM[t * 128 + ch] = run; }
    PT[part * 128 + ch] = run;
    __syncthreads();
    float off = 0.f, tot = 0.f;
#pragma unroll
    for (int p = 0; p < 4; ++p) { const float v = PT[p * 128 + ch]; if (p < part) off += v; tot += v; }
    for (int i = 0; i < 16; ++i) { const int r = part * 16 + i, t = dir ? 63 - r : r; CUM[t * 128 + ch] += off; }
    return tot;
}
__device__ __forceinline__ void hg_unit_a(const KCtx& a, int j, int unit, LAS unsigned char* lds) {
    const int tid = TIDX(a), lane = tid & 63, wave = rfl(tid >> 6);
    const int dir = unit & 1, h = (unit >> 1) & 3, c = unit >> 3;
    __syncthreads();
    hg_load_gates(a, j, c, h, dir, lds);
    { const bf16_t* proj = WSP(bf16_t, WS_PROJ);
#pragma unroll
      for (int i = 0; i < 2; ++i) { const int p = tid + NTHR * i, row = p >> 4, c8 = (p & 15) * 8;
          *(LAS u32x4*)(lds + HG_VV + row * HP + c8 * 2) = *(const u32x4*)(proj + (size_t)(c * HCH + row) * EVEN_IN + P_EVI + h * 128 + c8); } }
    __syncthreads();
    const float tot = hg_cumsum(a, dir, lds);
    { const int ch = tid & 127, part = tid >> 7; LAS float* CUM = (LAS float*)(lds + HG_CUM); const float lb = ((LAS float*)(lds + HG_LBV))[ch];
      for (int i = 0; i < 16; ++i) { const int r = part * 16 + i, t = dir ? 63 - r : r; LAS bf16_t* kp = (LAS bf16_t*)(lds + HG_KT + t * HP) + ch;
          const float f = bf2f(*kp), kd = (1.0f - lb) * sigm_f(-f); *kp = (bf16_t)f2bf(kd * __expf(tot - CUM[t * 128 + ch])); }
      if (part == 0) WSP(float, WS_HGD)[(size_t)unit * 128 + ch] = __expf(tot); }
    __syncthreads();
    f32x4 acc[8];
#pragma unroll
    for (int i = 0; i < 8; ++i) acc[i] = (f32x4){0.f, 0.f, 0.f, 0.f};
#pragma unroll
    for (int ks = 0; ks < 2; ++ks) { const bf16x8 af = trfrag(lds + HG_KT, HP, 32 * ks, 16 * wave, lane);
#pragma unroll
        for (int vt = 0; vt < 8; ++vt) { const bf16x8 bf = trfrag(lds + HG_VV, HP, 32 * ks, 16 * vt, lane); acc[vt] = mfma16(af, bf, acc[vt]); } }
    bf16_t* U = WSP(bf16_t, WS_HGU) + (size_t)unit * 16384;
#pragma unroll
    for (int vt = 0; vt < 8; ++vt)
#pragma unroll
        for (int r = 0; r < 4; ++r) U[(16 * wave + 4 * (lane >> 4) + r) * 128 + 16 * vt + (lane & 15)] = (bf16_t)f2bf(acc[vt][r]);
}
__device__ __forceinline__ int hg_seq(int dir, int i) { return dir == 0 ? i : (i < NCC ? NCC - 1 - i : NCH - 1 - (i - NCC)); }
__device__ __forceinline__ void ph_hg_scan(const KCtx& a) {
    const unsigned* U = WSP(unsigned, WS_HGU); unsigned* Sst = WSP(unsigned, WS_HGS); const float* Dd = WSP(float, WS_HGD);
    for (int e = a.bx * NTHR + TIDX(a); e < 8 * 8192; e += a.G * NTHR) {
        const int v2 = e & 63, k = (e >> 6) & 127, hd = e >> 13, h = hd >> 1, dir = hd & 1;
        float s0 = 0.f, s1 = 0.f;
        constexpr int SCB = (NCH % 26 == 0) ? 26 : ((NCH % 4 == 0) ? 4 : 1);
        for (int i = 0; i < NCH; i += SCB) {
            unsigned u[SCB]; float d[SCB];
#pragma unroll
            for (int q = 0; q < SCB; ++q) { const int unit = (hg_seq(dir, i + q) * 4 + h) * 2 + dir; u[q] = U[(size_t)unit * 8192 + k * 64 + v2]; d[q] = Dd[(size_t)unit * 128 + k]; }
#pragma unroll
            for (int q = 0; q < SCB; ++q) { const int unit = (hg_seq(dir, i + q) * 4 + h) * 2 + dir; Sst[(size_t)unit * 8192 + k * 64 + v2] = pk2(s0, s1); s0 = d[q] * s0 + bflo(u[q]); s1 = d[q] * s1 + bfhi(u[q]); }
        }
    }
}
__device__ __forceinline__ void hg_unit_c(const KCtx& a, int j, int c, int h, LAS unsigned char* lds) {
    const int tid = TIDX(a), lane = tid & 63, wave = rfl(tid >> 6);
    const bf16_t* proj = WSP(bf16_t, WS_PROJ);
    u32x4 rq[2], rv[2], fg0[2], fg1[2], gr[2]; u32x2 s0[8], s1[8];
#pragma unroll
    for (int i = 0; i < 2; ++i) { const int p = tid + NTHR * i, row = p >> 4, c8 = (p & 15) * 8; const bf16_t* src = proj + (size_t)(c * HCH + row) * EVEN_IN + h * 128 + c8;
        rq[i] = *(const u32x4*)(src + P_EVQ); rv[i] = *(const u32x4*)(src + P_EVI); fg0[i] = *(const u32x4*)(src + P_EVFF); fg1[i] = *(const u32x4*)(src + P_EVFF + 512); }
    { const bf16_t* Sg = WSP(bf16_t, WS_HGS) + (size_t)((c * 4 + h) * 2) * 16384;
#pragma unroll
      for (int i = 0; i < 8; ++i) { const int p = tid + NTHR * i, k = p >> 5, v4 = (p & 31) * 4; s0[i] = *(const u32x2*)(Sg + k * 128 + v4); s1[i] = *(const u32x2*)(Sg + 16384 + k * 128 + v4); } }
    { const int t = tid >> 3, v0 = (tid & 7) * 16; const bf16_t* gsrc = proj + (size_t)(c * HCH + t) * EVEN_IN + P_EVG + h * 128 + v0; gr[0] = *(const u32x4*)gsrc; gr[1] = *(const u32x4*)(gsrc + 8); }
    __syncthreads();
#pragma unroll
    for (int i = 0; i < 2; ++i) { const int p = tid + NTHR * i, row = p >> 4, c8 = (p & 15) * 8;
        u32x4 sq;
#pragma unroll
        for (int e = 0; e < 4; ++e) sq[e] = pk2(silu_f(bflo(rq[i][e])), silu_f(bfhi(rq[i][e])));
        *(LAS u32x4*)(lds + HG_QS + row * HP + c8 * 2) = sq;
        *(LAS u32x4*)(lds + HG_VV + row * HP + c8 * 2) = rv[i]; }
    const int rt = wave >> 1;
    f32x4 acc[4];
#pragma unroll
    for (int i = 0; i < 4; ++i) acc[i] = (f32x4){0.f, 0.f, 0.f, 0.f};
#pragma unroll
    for (int dir = 0; dir < 2; ++dir) {
        __syncthreads();
        hg_gates_from(a, j, h, dir, dir ? fg1 : fg0, lds);
        __syncthreads();
        (void)hg_cumsum(a, dir, lds);
        __syncthreads();
        const int tp = dir ? 31 : 32;
        LAS float* CUM = (LAS float*)(lds + HG_CUM);
        { const int ch = tid & 127, part = tid >> 7; const float lb = ((LAS float*)(lds + HG_LBV))[ch]; const float cp = CUM[tp * 128 + ch];
          for (int i = 0; i < 16; ++i) { const int r = part * 16 + i, t = dir ? 63 - r : r; const float cum = CUM[t * 128 + ch];
              LAS bf16_t* kp = (LAS bf16_t*)(lds + HG_KT + t * HP) + ch; const float f = bf2f(*kp), kd = (1.0f - lb) * sigm_f(-f);
              *kp = (bf16_t)f2bf(kd * __expf(fminf(cp - cum, 80.f)));
              const float qs = bf2f(*((LAS bf16_t*)(lds + HG_QS + t * HP) + ch));
              *((LAS bf16_t*)(lds + HG_QT + t * HP) + ch) = (bf16_t)f2bf(qs * __expf(fminf(cum - cp, 80.f))); } }
#pragma unroll
        for (int i = 0; i < 8; ++i) { const int p = tid + NTHR * i, k = p >> 5, v4 = (p & 31) * 4; const u32x2 s = dir ? s1[i] : s0[i]; const float e = __expf(CUM[tp * 128 + k]);
            u32x2 w; w.x = pk2(bflo(s.x) * e, bfhi(s.x) * e); w.y = pk2(bflo(s.y) * e, bfhi(s.y) * e); *(LAS u32x2*)(lds + HG_SS + k * HP + v4 * 2) = w; }
        __syncthreads();
#pragma unroll
        for (int ii = 0; ii < 2; ++ii) { const int st = 2 * (wave & 1) + ii; f32x4 pa = (f32x4){0.f, 0.f, 0.f, 0.f};
#pragma unroll
            for (int ks = 0; ks < 4; ++ks) pa = mfma16(rowfrag(lds + HG_QT, HP, 16 * rt, 32 * ks, lane), rowfrag(lds + HG_KT, HP, 16 * st, 32 * ks, lane), pa);
            const int s = 16 * st + (lane & 15);
#pragma unroll
            for (int r = 0; r < 4; ++r) { const int t = 16 * rt + 4 * (lane >> 4) + r; const bool keep = dir ? (s >= t) : (s <= t);
                *((LAS bf16_t*)(lds + HG_CUM + t * 144) + s) = (bf16_t)f2bf(keep ? pa[r] : 0.f); } }
        __syncthreads();
#pragma unroll
        for (int i = 0; i < 4; ++i) { const int ct = 4 * (wave & 1) + i;
#pragma unroll
            for (int ks = 0; ks < 2; ++ks) acc[i] = mfma16(rowfrag(lds + HG_CUM, 144, 16 * rt, 32 * ks, lane), trfrag(lds + HG_VV, HP, 32 * ks, 16 * ct, lane), acc[i]);
#pragma unroll
            for (int ks = 0; ks < 4; ++ks) acc[i] = mfma16(rowfrag(lds + HG_QT, HP, 16 * rt, 32 * ks, lane), trfrag(lds + HG_SS, HP, 32 * ks, 16 * ct, lane), acc[i]); }
    }
    __syncthreads();
    LAS float* OB = (LAS float*)(lds + HG_CUM);
#pragma unroll
    for (int i = 0; i < 4; ++i)
#pragma unroll
        for (int r = 0; r < 4; ++r) OB[(16 * rt + 4 * (lane >> 4) + r) * 128 + 16 * (4 * (wave & 1) + i) + (lane & 15)] = acc[i][r];
    __syncthreads();
    { const int t = tid >> 3, v0 = (tid & 7) * 16; float o[16]; float ss = 0.f;
#pragma unroll
      for (int q = 0; q < 16; ++q) { o[q] = OB[t * 128 + v0 + q]; ss += o[q] * o[q]; }
      ss += SHX(ss, 1, lane); ss += SHX(ss, 2, lane); ss += SHX(ss, 4, lane);
      const float r = 1.0f / sqrtf(ss * (1.0f / 128.0f) + 1e-6f);
      const float* gain = a.p->in[I_HGNG] + j * 128 + v0;
      bf16_t* dst = WSP(bf16_t, WS_MIX) + (size_t)(c * HCH + t) * D + h * 128 + v0;
#pragma unroll
      for (int hh = 0; hh < 2; ++hh) { const u32x4 grr = gr[hh]; u32x4 w;
#pragma unroll
          for (int e = 0; e < 4; ++e) { const int q = hh * 8 + 2 * e; w[e] = pk2(o[q] * r * gain[q] * silu_f(bflo(grr[e])), o[q + 1] * r * gain[q + 1] * silu_f(bfhi(grr[e]))); }
          *(u32x4*)(dst + hh * 8) = w; } }
}
constexpr int SG_W = 0, SG_VN = 34816, SG_ST = 69632;
__device__ __forceinline__ void sg_unit(const KCtx& a, int j, int cs, LAS unsigned char* lds) {
    const int tid = TIDX(a), lane = tid & 63, wave = rfl(tid >> 6);
    const bf16_t* proj = WSP(bf16_t, WS_PROJ); const int row0 = cs * SGC;
    __syncthreads();
    { const int t = tid >> 2, qd = tid & 3; float s = 0.f, s2 = 0.f;
      for (int i = 0; i < 16; ++i) { const u32x4 raw = *(const u32x4*)(proj + (size_t)(row0 + t) * EVEN_IN + P_EVV + qd * 128 + i * 8);
#pragma unroll
          for (int e = 0; e < 4; ++e) { const float x0 = gelu_f(bflo(raw[e])), x1 = gelu_f(bfhi(raw[e])); s += x0 + x1; s2 += x0 * x0 + x1 * x1; } }
      s += SHX(s, 1, lane); s += SHX(s, 2, lane); s2 += SHX(s2, 1, lane); s2 += SHX(s2, 2, lane);
      const float mean = s * (1.0f / 512.0f), var = fmaxf(s2 * (1.0f / 512.0f) - mean * mean, 0.f);
      if (qd == 0) { ((LAS float*)(lds + SG_ST))[t * 2] = mean; ((LAS float*)(lds + SG_ST))[t * 2 + 1] = 1.0f / sqrtf(var + 1e-5f); } }
    for (int g = 0; g < 4; ++g) {
        __syncthreads();
        const bf16_t* sgw = WSP(bf16_t, WS_SGW) + (size_t)(j * 4 + g) * 16384;
#pragma unroll
        for (int i = 0; i < 4; ++i) { const int p = tid + NTHR * i, r = p >> 4, c8 = (p & 15) * 8;
            *(LAS u32x4*)(lds + SG_W + r * HP + c8 * 2) = *(const u32x4*)(sgw + r * 128 + c8);
            const u32x4 raw = *(const u32x4*)(proj + (size_t)(row0 + r) * EVEN_IN + P_EVV + g * 128 + c8);
            const float mean = ((LAS float*)(lds + SG_ST))[r * 2], rstd = ((LAS float*)(lds + SG_ST))[r * 2 + 1];
            const float* lg = a.p->in[I_SGLNG] + j * 512 + g * 128 + c8; const float* lb = a.p->in[I_SGLNB] + j * 512 + g * 128 + c8;
            u32x4 w;
#pragma unroll
            for (int e = 0; e < 4; ++e) w[e] = pk2((gelu_f(bflo(raw[e])) - mean) * rstd * lg[2 * e] + lb[2 * e], (gelu_f(bfhi(raw[e])) - mean) * rstd * lg[2 * e + 1] + lb[2 * e + 1]);
            *(LAS u32x4*)(lds + SG_VN + r * HP + c8 * 2) = w; }
        __syncthreads();
        f32x4 acc[8];
#pragma unroll
        for (int i = 0; i < 8; ++i) acc[i] = (f32x4){0.f, 0.f, 0.f, 0.f};
#pragma unroll
        for (int ks = 0; ks < 4; ++ks) { const bf16x8 af = rowfrag(lds + SG_W, HP, 16 * wave, 32 * ks, lane);
#pragma unroll
            for (int ct = 0; ct < 8; ++ct) acc[ct] = mfma16(af, trfrag(lds + SG_VN, HP, 32 * ks, 16 * ct, lane), acc[ct]); }
        const float* sb = a.p->in[I_SGB] + (size_t)(j * 4 + g) * 128;
#pragma unroll
        for (int r = 0; r < 4; ++r) { const int t = 16 * wave + 4 * (lane >> 4) + r; const float bias = sb[t];
            const bf16_t* up = proj + (size_t)(row0 + t) * EVEN_IN + P_EVU + g * 128 + (lane & 15); bf16_t* dst = WSP(bf16_t, WS_MIX) + (size_t)(row0 + t) * D + 512 + g * 128 + (lane & 15);
#pragma unroll
            for (int ct = 0; ct < 8; ++ct) dst[16 * ct] = (bf16_t)f2bf((acc[ct][r] + bias) * gelu_f(bf2f(up[16 * ct]))); }
    }
}

constexpr int AT_SLOT = 32768, AT_V = 16384, AT_L = 3 * AT_SLOT, AT_Q = AT_L + 4096;
__device__ __forceinline__ int crow(int r, int hi) { return (r & 3) + 8 * (r >> 2) + 4 * hi; }
#ifdef CPU_SIM
#define PIN_P(w, l) do {} while (0)
#else
#define PIN_P(w, l) asm volatile("" : "+v"(w[0]), "+v"(w[1]), "+v"(l))
#endif
#define AT_KF(kb, d0) (*(const LAS bf16x8*)((kb) + (2 * (d0)) * 1024))
#define AT_VF(dst, vbh, db, ss) do { const LAS unsigned char* vp_ = (vbh) + (db) * 4096 + (ss) * 1024; const s16x4 lo_ = ds_tr16(vp_), hh_ = ds_tr16(vp_ + 512); \
        dst = (bf16x8){lo_[0], lo_[1], lo_[2], lo_[3], hh_[0], hh_[1], hh_[2], hh_[3]}; } while (0)
#define AT_STEP(pN, kbN, MN, DOS, pM, wN, lacc, DOX, OACC, wO, vbO, KNEXT, kbNext, vbNext) do { \
    _Pragma("unroll") for (int q_ = 0; q_ < 4; ++q_) { \
        bf16x8 kfc_ = kf, kfn_ = kf, qq_ = vfa, vfan_, vfbn_; \
        if (q_ < 3) { if (DOS) kfn_ = AT_KF(kbN, q_ + 1); } else if (KNEXT) kfn_ = AT_KF(kbNext, 0); \
        if (DOS) { qq_ = (MN == 0 || AV == 2) ? qf[q_] : *(const LAS bf16x8*)(qb1 + q_ * 1024); } \
        if (AV == 2) { vfan_ = vfa; vfbn_ = vfb; } else \
        if (q_ < 3) { AT_VF(vfan_, vbO, q_ + 1, 0); AT_VF(vfbn_, vbO, (q_ + 3) & 3, 1); } else { AT_VF(vfan_, vbNext, 0, 0); AT_VF(vfbn_, vbNext, 2, 1); } \
        SCHED_FENCE();     \
        if (AV == 6) { bf16x8 d0_, d1_; if (q_ < 3) { AT_VF(d0_, vbO, q_ + 1, 1); AT_VF(d1_, vbO, (q_ + 3) & 3, 0); } else { AT_VF(d0_, vbNext, 0, 1); AT_VF(d1_, vbNext, 2, 0); } asm volatile("" :: "v"(d0_), "v"(d1_)); } \
        if (AV == 7) { bf16x8 d0_ = AT_KF(kbN, q_), d1_ = AT_KF(kbN, (q_ + 1) & 3); asm volatile("" :: "v"(d0_), "v"(d1_)); } \
        if (AV != 3) { OACC[q_] = mfma32(__builtin_bit_cast(bf16x8, wO[0]), vfa, OACC[q_]); OACC[(q_ + 2) & 3] = mfma32(__builtin_bit_cast(bf16x8, wO[1]), vfb, OACC[(q_ + 2) & 3]); } \
        if (DOS && AV != 4) { if (q_ == 0) pN = mfma32(kfc_, qq_, negmv); else pN = mfma32(kfc_, qq_, pN); } \
        if (DOX) { _Pragma("unroll") for (int r_ = 4 * q_; r_ < 4 * q_ + 4; ++r_) { if (AV != 1) pM[r_] = fexp2(pM[r_]); lacc += pM[r_]; } \
            wN[q_ >> 1][(q_ & 1) * 2] = pk2(pM[4 * q_], pM[4 * q_ + 1]); wN[q_ >> 1][(q_ & 1) * 2 + 1] = pk2(pM[4 * q_ + 2], pM[4 * q_ + 3]); } \
        vfa = vfan_; vfb = vfbn_; kf = kfn_; \
        SCHED_FENCE(); } \
    if (DOX) { PIN_P(wN, lacc); } } while (0)
template <int AV>
__device__ __forceinline__ void attn_unit(const KCtx& a, int j, int h, int q0, int nkeys, LAS unsigned char* lds) {
    int tid = FRESH_TID(a); OPAQUE(tid);
    const int lane = tid & 63, wid = a.wv, r32 = lane & 31, hi = lane >> 5;
    const bf16_t* QR = WSP(bf16_t, WS_QR); const bf16_t* KR = WSP(bf16_t, WS_KR) + h * 128; const bf16_t* VP = WSP(bf16_t, WS_PROJ) + 2048 + h * 128;
    const int qrow = q0 + wid * 32 + r32, NT = nkeys / 64;
    __syncthreads();
    int koff = (lane * D + wid * 8) * 2, voff = ((16 * (wid & 3) + (lane >> 2)) * DQKV + (wid >> 2) * 32 + (lane & 3) * 8) * 2;
    OPAQUE(koff); OPAQUE(voff);
#define DMA_TILE(t, slot) do { const unsigned char* ks_ = (const unsigned char*)KR + (size_t)(t) * 64 * D * 2; const unsigned char* vs_ = (const unsigned char*)VP + (size_t)(t) * 64 * DQKV * 2; \
        LAS unsigned char* sl_ = lds + (slot) * AT_SLOT + wid * 1024; \
        glds16s(ks_, koff, sl_); glds16s(ks_ + 128, koff, sl_ + 8192); glds16s(vs_, voff, sl_ + AT_V); glds16s(vs_ + 128, voff, sl_ + AT_V + 8192); } while (0)
    DMA_TILE(0, 0);
    if (NT > 1) DMA_TILE(1, 1);
    bf16x8 qf[4];
    int qbo = AT_Q + wid * 4096 + hi * 512 + r32 * 16; OPAQUE(qbo);
    const LAS unsigned char* qb1 = lds + qbo;
#pragma unroll
    for (int d0 = 0; d0 < 4; ++d0) { qf[d0] = *(const bf16x8*)(QR + (size_t)qrow * D + h * 128 + d0 * 16 + hi * 8);
        *(LAS bf16x8*)(lds + qbo + d0 * 1024) = *(const bf16x8*)(QR + (size_t)qrow * D + h * 128 + 64 + d0 * 16 + hi * 8); }
    float negm;
    { float qs0 = 0.f, qs1 = 0.f;
#pragma unroll
      for (int d0 = 0; d0 < 4; ++d0) { const bf16x8 q1f = *(const LAS bf16x8*)(qb1 + d0 * 1024);
#pragma unroll
          for (int e = 0; e < 8; ++e) { const float x0 = bf2f((bf16_t)qf[d0][e]), x1 = bf2f((bf16_t)q1f[e]); qs0 += x0 * x0; qs1 += x1 * x1; } }
      qs0 += SHX(qs0, 32, lane); qs1 += SHX(qs1, 32, lane);
      const unsigned* kbw = WSP(unsigned, WS_CTL) + CW_KB + j * 128 + h * 16; float k0 = 0.f, k1 = 0.f;
#pragma unroll
      for (int e = 0; e < 8; ++e) { k0 += __builtin_bit_cast(float, kbw[e]); k1 += __builtin_bit_cast(float, kbw[8 + e]); }
      negm = -(sqrtf(fmaxf(qs0, qs1)) * sqrtf(fmaxf(k0, k1)) * 1.0005f + 1e-3f); }
    f32x16 O0[4], O1[4];
#pragma unroll
    for (int i = 0; i < 4; ++i)
#pragma unroll
        for (int r = 0; r < 16; ++r) { O0[i][r] = 0.f; O1[i][r] = 0.f; }
    float l0 = 0.f, l1 = 0.f;
    f32x16 negmv;
#pragma unroll
    for (int r = 0; r < 16; ++r) negmv[r] = negm;
    int vb = AT_V + ((lane >> 4) & 1) * 32 + (lane & 3) * 8 + (4 * hi + ((lane & 15) >> 2)) * 64; OPAQUE(vb);
    int kbo = hi * 1024 + r32 * 16; OPAQUE(kbo);
    f32x16 pA, pB; u32x4 wA[2], wB[2]; bf16x8 vfa, vfb, kf;
    WAIT_DMA_BAR();
    int sc = 0, sn = AT_SLOT, sp = 2 * AT_SLOT;
    {
#pragma unroll
        for (int r = 0; r < 16; ++r) { pA[r] = negm; pB[r] = negm; }
#pragma unroll
        for (int d0 = 0; d0 < 4; ++d0) { pB = mfma32(AT_KF(lds + kbo, d0), qf[d0], pB); pA = mfma32(AT_KF(lds + kbo + 8192, d0), *(const LAS bf16x8*)(qb1 + d0 * 1024), pA); }
#pragma unroll
        for (int r = 0; r < 16; ++r) { pB[r] = fexp2(pB[r]); l0 += pB[r]; }
#pragma unroll
        for (int e = 0; e < 4; ++e) { wA[0][e] = pk2(pB[2 * e], pB[2 * e + 1]); wA[1][e] = pk2(pB[8 + 2 * e], pB[8 + 2 * e + 1]); }
        AT_VF(vfa, lds + vb, 0, 0); AT_VF(vfb, lds + vb, 2, 1); kf = AT_KF(lds + kbo + 512, 0);
    }
    for (int kt = 0; kt < NT; ++kt) {
        const bool more = kt + 1 < NT;
        SCHED_FENCE();
        const LAS unsigned char* kc = lds + kbo + sc; const LAS unsigned char* kn = lds + kbo + sn; const LAS unsigned char* vc = lds + vb + sc; const LAS unsigned char* vn = lds + vb + sn;
        AT_STEP(pB, kc + 512, 0, true, pA, wB, l1, true, O0, wA, vc, true, kc + 512 + 8192, vc);
        AT_STEP(pA, kc + 512 + 8192, 1, true, pB, wA, l0, true, O1, wB, vc, false, kc, vc + 2048);
        if (AV != 5) { WAIT_DMA_BAR_KEEP();
        if (kt + 2 < NT) DMA_TILE(kt + 2, (kt + 2) % 3); }
        if (more) { kf = AT_KF(kn, 0);
            AT_STEP(pB, kn, 0, true, pA, wB, l1, true, O0, wA, vc + 2048, true, kn + 8192, vc + 2048);
            AT_STEP(pA, kn + 8192, 1, true, pB, wA, l0, true, O1, wB, vc + 2048, true, kn + 512, vn);
        } else {
            AT_STEP(pB, kn, 0, false, pA, wB, l1, true, O0, wA, vc + 2048, false, kn, vc + 2048);
            AT_STEP(pA, kn, 1, false, pB, wA, l0, false, O1, wB, vc + 2048, false, kn, vc + 2048);
        }
        { const int t_ = sc; sc = sn; sn = sp; sp = t_; }
    }
#undef DMA_TILE
    SCHED_FENCE();
    int tid3 = FRESH_TID(a); OPAQUE(tid3);
    const int lane3 = tid3 & 63, wid3 = a.wv, r3 = lane3 & 31, hi3 = lane3 >> 5;
    LAS float* lb = (LAS float*)(lds + AT_L) + wid3 * 128;
    lb[hi3 * 32 + r3] = l0; lb[64 + hi3 * 32 + r3] = l1;
    WAVE_SYNC();
    const float lam = WSP(float, WS_SMALL + SM_LAMF)[j];
    const float lam_init = 0.8f - 0.6f * expf(-0.3f * (float)(2 * j + 1));
    const float* subg = a.p->in[I_DASUBG] + j * 128;
    bf16_t* dst = WSP(bf16_t, WS_MIX) + (size_t)(q0 + wid3 * 32) * D + h * 128 + r3;
#pragma unroll
    for (int r = 0; r < 16; ++r) { SCHED_FENCE(); const int q = crow(r, hi3); const float li0 = 1.0f / (lb[q] + lb[32 + q]), li1 = lam / (lb[64 + q] + lb[96 + q]);
        float o[4]; float ss = 0.f;
#pragma unroll
        for (int db = 0; db < 4; ++db) { o[db] = O0[db][r] * li0 - O1[db][r] * li1; ss += o[db] * o[db]; }
#pragma unroll
        for (int ofs = 1; ofs < 32; ofs <<= 1) ss += SHX(ss, ofs, lane3);
        const float rn = (1.0f - lam_init) / sqrtf(ss * (1.0f / 128.0f) + 1e-5f);
#pragma unroll
        for (int db = 0; db < 4; ++db) dst[(size_t)q * D + db * 32] = (bf16_t)f2bf(o[db] * rn * subg[db * 32 + r3]); }
}
template <int AV = 0>
__device__ __forceinline__ void ph_attn(const KCtx& a, int j, LAS unsigned char* lds) {
    constexpr int NQT = SEQ / 256;
    for (int u = a.bx; u < NQT * 8 + 8; u += a.G) {
        const bool lat = u < NQT * 8;
        attn_unit<AV>(a, j, lat ? (u & 7) : (u - NQT * 8), lat ? CTX + (u >> 3) * 256 : 0, lat ? T : CTX, lds);
    }
}

__device__ __forceinline__ void ph_moe_assign(const KCtx& a, int j) {
    const int tid = TIDX(a), lane = tid & 63, wave = rfl(tid >> 6), gw = a.bx * NWAVES + wave, NGW = a.G * NWAVES;
    unsigned* cnt = WSP(unsigned, WS_CTL) + CW_MOECNT + j * 64; unsigned* cur = WSP(unsigned, WS_CTL) + CW_MOECUR + j * 64;
    int start[NEXP + 1]; start[0] = 0;
#pragma unroll
    for (int e = 0; e < NEXP; ++e) start[e + 1] = start[e] + (int)((cnt[e] + 255u) / 256u) * 256;
    int* tab = WSP(int, WS_SMALL + SM_MOETAB);
    if (a.bx == 0 && tid == 0) { const int ntr = start[NEXP] / 256; tab[0] = ntr;
        for (int rt = 0; rt < ntr; ++rt) { int e = 0;
#pragma unroll
            for (int q = 1; q < NEXP; ++q) if (rt * 256 >= start[q]) e = q;
            tab[16 + rt] = e; } }
    const int* te = WSP(int, WS_TOK); int* tp = WSP(int, WS_TOK + (size_t)T * 16);
    const bf16_t* H = WSP(bf16_t, WS_H); bf16_t* AG = WSP(bf16_t, WS_AG);
    int mypos = 0;
    { const int idx = gw + lane * NGW;
      if (idx < 2 * T) { const int e = te[idx]; int st = 0;
#pragma unroll
          for (int q = 0; q < NEXP; ++q) if (q == e) st = start[q];
          mypos = st + (int)atomicAdd(cur + e, 1u); tp[idx] = mypos; } }
    int it = 0;
    for (int idx = gw; idx < 2 * T; idx += NGW, ++it) {
        const int pos = SHI(mypos, it, lane);
        const u32x4* src = (const u32x4*)((const unsigned char*)H + (size_t)(idx >> 1) * D); u32x4* dst = (u32x4*)((unsigned char*)AG + (size_t)pos * D);
        dst[lane] = src[lane];
    }
}

constexpr int N_PHASES = 38;
__global__ void __launch_bounds__(NTHR, 2) fwd_kernel(KArgs ka) {
#ifdef CPU_SIM
    unsigned char* lds = sim_lds();
#else
    extern __shared__ __attribute__((aligned(16))) unsigned char lds_raw[];
    LAS unsigned char* lds = (LAS unsigned char*)lds_raw;
#endif
    KCtx a;
#ifdef CPU_SIM
    a.p = &ka; a.wv = (int)threadIdx.x >> 6; a.tid = (int)threadIdx.x; a.bx = (int)blockIdx.x; a.G = (int)gridDim.x; a.L = lds;
#define NEWCTX() do {} while (0)
#else
    const int wv0 = rfl((int)threadIdx.x >> 6); a.wv = wv0;
#define NEWCTX() do { unsigned long long kp_ = (unsigned long long)__builtin_amdgcn_kernarg_segment_ptr(); asm volatile("" : "+s"(kp_)); a.p = (KArgP)kp_; \
        int b_ = (int)blockIdx.x, g_ = (int)gridDim.x, w_ = wv0, l_ = 0; asm volatile("" : "+s"(b_), "+s"(g_), "+s"(w_), "+s"(l_)); a.bx = b_; a.G = g_; a.wv = w_; a.L = lds + l_; \
        unsigned z2_ = 0u; asm volatile("" : "+s"(z2_)); int t_ = w_ * 64 + (int)__builtin_amdgcn_mbcnt_hi(~0u, __builtin_amdgcn_mbcnt_lo(~0u, z2_)); asm volatile("" : "+v"(t_)); a.tid = t_; } while (0)
    NEWCTX();
#endif
    const int tid = TIDX(a);
    for (int u = tid; u < (LDS_BYTES - LDS_MISC) / 4; u += NTHR) ((LAS unsigned*)(lds + LDS_MISC))[u] = 0u;
    __syncthreads();
#if !defined(CPU_SIM) && N_LAUNCH_MODE == 0
    XcdBarrier bar = xcd_barrier_post(WSP(unsigned, WS_CTL) + CW_BAR, (volatile LAS unsigned*)(lds + LDS_MISC + 32), tid);
#define SEAM() do { XcdBarrier b_ = bar; unsigned long long bp_ = (unsigned long long)b_.bar; unsigned bxx_ = b_.x; asm volatile("" : "+s"(bp_), "+s"(bxx_)); b_.bar = (unsigned*)bp_; b_.x = bxx_; xcd_barrier(b_, FRESH_TID(a)); } while (0)
#else
#define SEAM() do {} while (0)
#endif
    const int lo = a.p->ph_lo, hi = a.p->ph_hi;
#ifdef ONLY_SITE
#define SITE(k) (ONLY_SITE == (k))
#else
#define SITE(k) 1
#endif
#ifdef PROBE_SITE
#define REPS(k) ((PROBE_SITE == (k)) ? PROBE_REPS : 1)
#else
#define REPS(k) 1
#endif
#define IN(p) (lo <= (p) && (p) < hi)
#define ENDPH(p) do { if (IN((p) + 1)) SEAM(); } while (0)
#define ENDPH2(p) do { if (IN((p) + 2)) SEAM(); } while (0)
#define modv WSP(float, WS_SMALL + SM_MODV)
#define moetab WSP(int, WS_SMALL + SM_MOETAB)

    if (SITE(0) && IN(0)) { NEWCTX(); for (int rep_ = 0; rep_ < REPS(0); ++rep_) { ph_prologue(a, a.L); } ENDPH(0); }
    for (int pr = 0; pr < 2; ++pr) {
        const int j = pr, Le = 2 * pr, Lo = 2 * pr + 1, be = 1 + 9 * Le, bo = 1 + 9 * Lo;
        if (SITE(1) && IN(be + 0)) { NEWCTX(); for (int rep_ = 0; rep_ < REPS(1); ++rep_) { if (pr == 0) ph_rowpass<false, false, false, true>(a, Le, 0); else ph_rowpass<true, false, false>(a, Le, 0); } ENDPH(be + 0); }
        if (SITE(2) && IN(be + 1)) { NEWCTX(); for (int rep_ = 0; rep_ < REPS(2); ++rep_) {
            pg8::Gemm g{WSP(bf16_t, WS_H), WSP(bf16_t, WS_WIN + j * SZ_WIN), T, EVEN_IN, D}; pg8::StaticOrder S; S.init(T, EVEN_IN, a.G, a.bx);
            pg8::EpiStoreBf16 E{WSP(bf16_t, WS_PROJ), EVEN_IN, EVEN_IN / 256};
            pg8::gemm_phase<pg8::EpiStoreBf16, pg8::StaticOrder, true, true>(a.L, g, S, E, TIDX(a)); } ENDPH(be + 1); }
        if (SITE(3) && IN(be + 2)) { NEWCTX(); for (int rep_ = 0; rep_ < REPS(3); ++rep_) { for (int u = a.bx; u < NSG + NCH * 8; u += a.G) { if (u < NSG) sg_unit(a, j, u, a.L); else hg_unit_a(a, j, u - NSG, a.L); } } ENDPH(be + 2); }
        if (SITE(4) && IN(be + 3)) { NEWCTX(); for (int rep_ = 0; rep_ < REPS(4); ++rep_) { ph_hg_scan(a); } ENDPH(be + 3); }
        if (SITE(5) && IN(be + 4)) { NEWCTX(); for (int rep_ = 0; rep_ < REPS(5); ++rep_) { for (int u = a.bx; u < NCH * 4; u += a.G) hg_unit_c(a, j, u >> 2, u & 3, a.L); } ENDPH(be + 4); }
        if (SITE(6) && IN(be + 5)) { NEWCTX(); for (int rep_ = 0; rep_ < REPS(6); ++rep_) {
            pg8::Gemm g{WSP(bf16_t, WS_MIX) + (size_t)CTX * D, WSP(bf16_t, WS_WEO + j * SZ_WSQ), SEQ, D, D}; pg8::StaticOrder S; S.init(SEQ, D, a.G, a.bx);
            pg8::EpiResid E{pr == 0 ? a.p->in[I_X] : WSP(float, WS_X) + (size_t)CTX * D, WSP(float, WS_X1) + (size_t)CTX * D, modv + ((Le * 2 + 0) * 6 + 2) * 1024, modv + ((Le * 2 + 0) * 6 + 2) * 1024};
            pg8::gemm_phase<pg8::EpiResid, pg8::StaticOrder, true, true>(a.L, g, S, E, TIDX(a));
            ctx_gemm<1>(a, WSP(bf16_t, WS_MIX), WSP(bf16_t, WS_WEO + j * SZ_WSQ), D, D, nullptr, 0, pr == 0 ? a.p->in[I_CTX] : WSP(float, WS_X), WSP(float, WS_X1), modv + ((Le * 2 + 1) * 6 + 2) * 1024, a.L); } ENDPH(be + 5); }
        if (SITE(7) && IN(be + 6)) { NEWCTX(); for (int rep_ = 0; rep_ < REPS(7); ++rep_) { ph_rowpass<false, false, false>(a, Le, 1); } ENDPH(be + 6); }
        if (SITE(8) && IN(be + 7)) { NEWCTX(); for (int rep_ = 0; rep_ < REPS(8); ++rep_) {
            pg8::Gemm g{WSP(bf16_t, WS_H), WSP(bf16_t, WS_WGU + j * SZ_WGU), T, 2 * DFF, D}; pg8::StaticOrder S; S.init(T, 2 * DFF, a.G, a.bx);
            pg8::EpiSwiglu E{WSP(bf16_t, WS_HFF), DFF, 2 * DFF / 256};
            pg8::gemm_phase<pg8::EpiSwiglu, pg8::StaticOrder, true, true>(a.L, g, S, E, TIDX(a)); } ENDPH(be + 7); }
        if (SITE(9) && IN(be + 8)) { NEWCTX(); for (int rep_ = 0; rep_ < REPS(9); ++rep_) {
            pg8::Gemm g{WSP(bf16_t, WS_HFF) + (size_t)CTX * DFF, WSP(bf16_t, WS_WDN + j * SZ_WDN), SEQ, D, DFF}; pg8::StaticOrder S; S.init(SEQ, D, a.G, a.bx);
            pg8::EpiResid E{WSP(float, WS_X1) + (size_t)CTX * D, WSP(float, WS_X) + (size_t)CTX * D, modv + ((Le * 2 + 0) * 6 + 5) * 1024, modv + ((Le * 2 + 0) * 6 + 5) * 1024};
            pg8::gemm_phase<pg8::EpiResid, pg8::StaticOrder, true, true>(a.L, g, S, E, TIDX(a));
            ctx_gemm<1>(a, WSP(bf16_t, WS_HFF), WSP(bf16_t, WS_WDN + j * SZ_WDN), DFF, D, nullptr, 0, WSP(float, WS_X1), WSP(float, WS_X), modv + ((Le * 2 + 1) * 6 + 5) * 1024, a.L); } ENDPH(be + 8); }
        if (SITE(10) && IN(bo + 0)) { NEWCTX(); for (int rep_ = 0; rep_ < REPS(10); ++rep_) { ph_rowpass<false, false, false>(a, Lo, 0); if (pr == 1) { int itb = 0; moe_weights(a, 1, a.L, itb); } } ENDPH(bo + 0); }
        if (SITE(11) && IN(bo + 1)) { NEWCTX(); for (int rep_ = 0; rep_ < REPS(11); ++rep_) {
            pg8::Gemm g{WSP(bf16_t, WS_H) + (size_t)CTX * D, WSP(bf16_t, WS_WQKV + j * SZ_WQKV), SEQ, DQKV, D}; pg8::StaticOrder S; S.init(SEQ, DQKV, a.G, a.bx);
            pg8::EpiQkvRope E{WSP(bf16_t, WS_QR), WSP(bf16_t, WS_KR), WSP(bf16_t, WS_PROJ) + (size_t)CTX * DQKV, WSP(float, WS_SMALL + SM_ROPE), WSP(unsigned, WS_CTL) + CW_KB + j * 128};
            pg8::gemm_phase<pg8::EpiQkvRope, pg8::StaticOrder, true, true>(a.L, g, S, E, TIDX(a));
            ctx_gemm<3>(a, WSP(bf16_t, WS_H), WSP(bf16_t, WS_WQKV + j * SZ_WQKV), D, DQKV, WSP(bf16_t, WS_PROJ), DQKV, (const float*)(WSP(unsigned, WS_CTL) + CW_KB + j * 128), (float*)WSP(bf16_t, WS_QR), (const float*)WSP(bf16_t, WS_KR), a.L); } ENDPH2(bo + 1); }
        if (SITE(13) && IN(bo + 3)) { NEWCTX(); for (int rep_ = 0; rep_ < REPS(13); ++rep_) {
#ifdef PROBE_VARIANT
            if (a.p->variant != 0) ph_attn<PROBE_VARIANT>(a, j, a.L); else
#endif
            ph_attn<0>(a, j, a.L); } ENDPH(bo + 3); }
        if (SITE(14) && IN(bo + 4)) { NEWCTX(); for (int rep_ = 0; rep_ < REPS(14); ++rep_) {
            pg8::Gemm g{WSP(bf16_t, WS_MIX) + (size_t)CTX * D, WSP(bf16_t, WS_WAO + j * SZ_WSQ), SEQ, D, D}; pg8::StaticOrder S; S.init(SEQ, D, a.G, a.bx);
            pg8::EpiResid E{WSP(float, WS_X) + (size_t)CTX * D, WSP(float, WS_X1) + (size_t)CTX * D, modv + ((Lo * 2 + 0) * 6 + 2) * 1024, modv + ((Lo * 2 + 0) * 6 + 2) * 1024};
            pg8::gemm_phase<pg8::EpiResid, pg8::StaticOrder, true, true>(a.L, g, S, E, TIDX(a));
            ctx_gemm<1>(a, WSP(bf16_t, WS_MIX), WSP(bf16_t, WS_WAO + j * SZ_WSQ), D, D, nullptr, 0, WSP(float, WS_X), WSP(float, WS_X1), modv + ((Lo * 2 + 1) * 6 + 2) * 1024, a.L); } ENDPH(bo + 4); }
        if (SITE(15) && IN(bo + 5)) { NEWCTX(); for (int rep_ = 0; rep_ < REPS(15); ++rep_) { ph_rowpass<false, true, false>(a, Lo, 1); } ENDPH(bo + 5); }
        if (SITE(16) && IN(bo + 6)) { NEWCTX(); for (int rep_ = 0; rep_ < REPS(16); ++rep_) { ph_moe_assign(a, j); } ENDPH(bo + 6); }
        if (SITE(17) && IN(bo + 7)) { NEWCTX(); for (int rep_ = 0; rep_ < REPS(17); ++rep_) {
            pg8::Gemm g{WSP(bf16_t, WS_AG), WSP(bf16_t, WS_MGU), NR_MAX, 2 * EFF, D / 2}; pg8::MoeOrder S{moetab, 2 * EFF / 256, a.G, a.bx};
            pg8::EpiSwigluF8 E{WSP(unsigned char, WS_HM), EFF, 2 * EFF / 256, 1.0f / (F8_SH * F8_SW)};
            pg8::gemm_phase<pg8::EpiSwigluF8, pg8::MoeOrder, true, true>(a.L, g, S, E, TIDX(a)); } ENDPH(bo + 7); }
        if (SITE(18) && IN(bo + 8)) { NEWCTX(); for (int rep_ = 0; rep_ < REPS(18); ++rep_) {
            pg8::Gemm g{WSP(bf16_t, WS_HM), WSP(bf16_t, WS_MDN), NR_MAX, D, EFF / 2}; pg8::MoeOrder S{moetab, D / 256, a.G, a.bx};
            pg8::EpiStoreBf16S E{WSP(bf16_t, WS_Y), D, D / 256, 1.0f / (F8_SM * F8_SW)};
            pg8::gemm_phase<pg8::EpiStoreBf16S, pg8::MoeOrder, true, true>(a.L, g, S, E, TIDX(a)); } ENDPH(bo + 8); }
    }
    if (SITE(19) && IN(37)) { NEWCTX(); for (int rep_ = 0; rep_ < REPS(19); ++rep_) { ph_rowpass<true, false, true>(a, 3, 0); } }
#undef IN
#undef modv
#undef moetab
#undef ENDPH
#undef SEAM
}

#ifdef CPU_SIM
#ifndef SIM_GRID
#define SIM_GRID 16
#endif
int g_sim_ph_lo = 0, g_sim_ph_hi = N_PHASES;
extern "C" void kernel_launch(void* const* d_in, const int* in_sizes, int n_in, void* d_out, int out_size, void* d_ws, size_t ws_size, hipStream_t stream) {
    KArgs a{}; for (int i = 0; i < 26; ++i) a.in[i] = (const float*)d_in[i]; a.out = (float*)d_out; a.ws = (unsigned char*)d_ws;
    if (g_sim_ph_lo == 0) memset((char*)d_ws + WS_CTL, 0, CTL_BYTES);
    for (int p = g_sim_ph_lo; p < g_sim_ph_hi; ++p) { KArgs ap = a; ap.ph_lo = p; ap.ph_hi = p + 1;
        pg8::g_cur_phase = p; { static int once = 0; if (!once) { once = 1; const char* e = getenv("FP8_MASK"); if (e) pg8::g_fp8_mask = strtoull(e, nullptr, 0); const char* ea = getenv("FP8_SA"); if (ea) pg8::g_fp8_sa = atof(ea); const char* eb = getenv("FP8_SB"); if (eb) pg8::g_fp8_sb = atof(eb); fprintf(stderr, "[sim] fp8 mask %llx sa %g sb %g\n", pg8::g_fp8_mask, pg8::g_fp8_sa, pg8::g_fp8_sb); } }
        sim_launch([&]() { fwd_kernel(ap); }, SIM_GRID, NTHR, LDS_BYTES, 8); }
}
#else
extern "C" void kernel_launch(void* const* d_in, const int* in_sizes, int n_in, void* d_out, int out_size, void* d_ws, size_t ws_size, hipStream_t stream) {
    static int grid = 0;
    if (grid == 0) {
        if (n_in != 26 || out_size != SEQ * D || ws_size < WS_END) { fprintf(stderr, "kernel_launch: unexpected shapes (n_in %d out %d ws %zu need %zu)\n", n_in, out_size, ws_size, (size_t)WS_END); grid = -1; return; }
        int dev = 0, cus = 0;
        if (hipGetDevice(&dev) != hipSuccess || hipDeviceGetAttribute(&cus, hipDeviceAttributeMultiprocessorCount, dev) != hipSuccess) { grid = -1; return; }
        if (hipFuncSetAttribute((const void*)fwd_kernel, hipFuncAttributeMaxDynamicSharedMemorySize, LDS_BYTES) != hipSuccess) { fprintf(stderr, "kernel_launch: hipFuncSetAttribute failed\n"); grid = -1; return; }
        int per_cu = 0;
        if (hipOccupancyMaxActiveBlocksPerMultiprocessor(&per_cu, (const void*)fwd_kernel, NTHR, LDS_BYTES) != hipSuccess || per_cu < 1) fprintf(stderr, "kernel_launch: occupancy query says %d\n", per_cu);
        (void)hipGetLastError();
        grid = cus;
    }
    if (grid < 0) return;
    (void)hipMemsetAsync((char*)d_ws + WS_CTL, 0, CTL_BYTES, stream);
    KArgs a{};
    for (int i = 0; i < 26; ++i) a.in[i] = (const float*)d_in[i];
    a.out = (float*)d_out; a.ws = (unsigned char*)d_ws;
#if N_LAUNCH_MODE == 0 && defined(PROBE_PHASE) && defined(PROBE_VARIANT)
    a.variant = 0; a.ph_lo = 0; a.ph_hi = PROBE_PHASE;
    hipLaunchKernelGGL(fwd_kernel, dim3(grid), dim3(NTHR), LDS_BYTES, stream, a);
    for (int r = 1; r < PROBE_REPS; ++r) { (void)hipMemsetAsync((char*)d_ws + WS_CTL + CW_BAR * 4, 0, XCD_BAR_WORDS * 4, stream); a.variant = 1; a.ph_lo = PROBE_PHASE; a.ph_hi = PROBE_PHASE + 1;
        hipLaunchKernelGGL(fwd_kernel, dim3(grid), dim3(NTHR), LDS_BYTES, stream, a); }
    (void)hipMemsetAsync((char*)d_ws + WS_CTL + CW_BAR * 4, 0, XCD_BAR_WORDS * 4, stream); a.variant = 0; a.ph_lo = PROBE_PHASE; a.ph_hi = N_PHASES;
    hipLaunchKernelGGL(fwd_kernel, dim3(grid), dim3(NTHR), LDS_BYTES, stream, a);
#elif N_LAUNCH_MODE == 0 && defined(PROBE_PHASE)
    a.ph_lo = 0; a.ph_hi = PROBE_PHASE + 1;
    hipLaunchKernelGGL(fwd_kernel, dim3(grid), dim3(NTHR), LDS_BYTES, stream, a);
    for (int r = 1; r < PROBE_REPS; ++r) { (void)hipMemsetAsync((char*)d_ws + WS_CTL + CW_BAR * 4, 0, XCD_BAR_WORDS * 4, stream); a.ph_lo = PROBE_PHASE; a.ph_hi = PROBE_PHASE + 1;
        hipLaunchKernelGGL(fwd_kernel, dim3(grid), dim3(NTHR), LDS_BYTES, stream, a); }
    if (PROBE_PHASE + 1 < N_PHASES) { (void)hipMemsetAsync((char*)d_ws + WS_CTL + CW_BAR * 4, 0, XCD_BAR_WORDS * 4, stream); a.ph_lo = PROBE_PHASE + 1; a.ph_hi = N_PHASES;
        hipLaunchKernelGGL(fwd_kernel, dim3(grid), dim3(NTHR), LDS_BYTES, stream, a); }
#elif N_LAUNCH_MODE == 0
    a.ph_lo = 0; a.ph_hi = N_PHASES;
    hipLaunchKernelGGL(fwd_kernel, dim3(grid), dim3(NTHR), LDS_BYTES, stream, a);
#else
    for (int p = 0; p < N_PHASES; ++p) { a.ph_lo = p; a.ph_hi = p + 1; hipLaunchKernelGGL(fwd_kernel, dim3(grid), dim3(NTHR), LDS_BYTES, stream, a); }
#endif
}
#endif
```

```cpp
#ifdef CPU_SIM
#include "cpu_sim.h"
typedef void* hipStream_t;
#else
#include <hip/hip_runtime.h>
#include <cstdio>
#include <cstdint>
#endif
#include <cmath>

#ifndef SEQ_LEN
#define SEQ_LEN 16384
#endif
#ifndef N_LAUNCH_MODE
#define N_LAUNCH_MODE 0
#endif

typedef unsigned short bf16_t;
typedef short bf16x8 __attribute__((ext_vector_type(8)));
typedef short s16x4 __attribute__((ext_vector_type(4)));
typedef float f32x4 __attribute__((ext_vector_type(4)));
typedef float f32x2 __attribute__((ext_vector_type(2)));
typedef float f32x16 __attribute__((ext_vector_type(16)));
typedef unsigned u32x4 __attribute__((ext_vector_type(4)));
typedef unsigned u32x2 __attribute__((ext_vector_type(2)));

constexpr int D = 1024, SEQ = SEQ_LEN, CTX = 256, T = SEQ + CTX;
constexpr int GRID_W = 64;
constexpr int EVEN_IN = 3584, DFF = 2816, EFF = 3584, NEXP = 8, DQKV = 3072;
constexpr int HCH = 64, NCH = T / HCH, NCC = CTX / HCH;
constexpr int SGC = 128, NSG = T / SGC;
constexpr int NR_MAX = ((2 * T + NEXP * 255 + 255) / 256) * 256;
constexpr int NTR_MAX = NR_MAX / 256;
constexpr int NWAVES = 8, NTHR = 512;
constexpr float QSCALE = 0.125f * 1.4426950408889634f;

constexpr size_t MiB = 1u << 20;
constexpr size_t al1(size_t x) { return (x + MiB - 1) / MiB * MiB; }
constexpr size_t WS_CTL = 0, CTL_BYTES = 1 * MiB;
constexpr size_t WS_SMALL = WS_CTL + CTL_BYTES;
constexpr size_t WS_TOK = WS_SMALL + 1 * MiB;
constexpr size_t WS_QN = WS_TOK + al1((size_t)T * 24);
constexpr size_t WS_HGD = WS_QN + al1((size_t)T * 32);
constexpr size_t WS_WIN = WS_HGD + al1((size_t)NCH * 8 * 512);
constexpr size_t SZ_WIN = (size_t)EVEN_IN * D * 2, SZ_WSQ = (size_t)D * D * 2, SZ_WGU = (size_t)2 * DFF * D * 2, SZ_WDN = (size_t)D * DFF * 2, SZ_WQKV = (size_t)DQKV * D * 2;
constexpr size_t WS_WEO = WS_WIN + 2 * SZ_WIN, WS_WGU = WS_WEO + 2 * SZ_WSQ, WS_WDN = WS_WGU + 2 * SZ_WGU, WS_WQKV = WS_WDN + 2 * SZ_WDN, WS_WAO = WS_WQKV + 2 * SZ_WQKV;
constexpr size_t WS_SGW = WS_WAO + 2 * SZ_WSQ;
constexpr size_t WS_MGU = al1(WS_SGW + 2 * 4 * 128 * 128 * 2);
constexpr size_t SZ_MGU = (size_t)NEXP * 2 * EFF * D * 2, SZ_MDN = (size_t)NEXP * D * EFF * 2;
constexpr size_t WS_MDN = WS_MGU + SZ_MGU;
constexpr size_t WS_X = al1(WS_MDN + SZ_MDN);
constexpr size_t WS_H = WS_X + al1((size_t)T * D * 4);
constexpr size_t WS_B = WS_H + al1((size_t)T * D * 2);
constexpr size_t WS_PROJ = WS_B;
constexpr size_t WS_HGU = WS_PROJ + al1((size_t)T * EVEN_IN * 2);
constexpr size_t WS_QR = WS_PROJ + al1((size_t)T * DQKV * 2);
constexpr size_t WS_KR = WS_QR + al1((size_t)T * D * 2);
constexpr size_t WS_MIX = WS_HGU + al1((size_t)NCH * 8 * 65536);
constexpr size_t WS_HFF = WS_B;
constexpr size_t WS_AG = WS_B;
constexpr size_t WS_HM = WS_AG + al1((size_t)NR_MAX * D * 2);
constexpr size_t WS_Y = WS_HM + al1((size_t)NR_MAX * EFF * 2);
constexpr size_t WS_END_A = WS_MIX + al1((size_t)T * D * 2), WS_END_B = WS_Y + al1((size_t)NR_MAX * D * 2);
constexpr size_t WS_END0 = WS_END_A > WS_END_B ? WS_END_A : WS_END_B;
constexpr size_t WS_HGS = WS_END0;
constexpr size_t WS_X1 = WS_HGS + al1((size_t)NCH * 8 * 65536);
constexpr size_t WS_END = WS_X1 + al1((size_t)T * D * 4);
static_assert(WS_KR + al1((size_t)T * D * 2) <= WS_MIX, "odd-layer q/k buffers below the mixer output");
constexpr int CW_BAR = 4096;
constexpr int CW_MOECNT = 8192, CW_MOECUR = 8192 + 128, CW_KMAX = 8192 + 256, CW_MOEWQ = 8192 + 384, CW_KB = 8192 + 512;
constexpr size_t SM_MODV = 0, SM_ROPE = 256 * 1024  , SM_LAMF = 512 * 1024, SM_MOETAB = 768 * 1024;

constexpr int LDS_MISC = 143360, LDS_BYTES = 147456, LDS_MOE = LDS_MISC + 2048;

#ifdef CPU_SIM
#define LAS
#define GAS
#define WAVE_SYNC() sim_wave_sync()
#define VM_WAIT()
static inline f32x16 mfma32(bf16x8 a, bf16x8 b, f32x16 c) { return sim_mfma32x32x16(a, b, c); }
static inline f32x4 mfma16(bf16x8 a, bf16x8 b, f32x4 c) { return sim_mfma16x16x32(a, b, c); }
static inline s16x4 ds_tr16(const unsigned char* p) { return sim_ds_read_tr16(p); }
static inline float fexp2(float x) { return exp2f(x); }
static inline float frcp(float x) { return 1.0f / x; }
static inline float frsq(float x) { return 1.0f / sqrtf(x); }
static inline int rfl(int x) { return x; }
#define OPAQUE(x) do {} while (0)
#define SETPRIO(n) do {} while (0)
#define BURN(x) do {} while (0)
#define SCHED_FENCE() do {} while (0)
static inline void glds16(const void* gsrc, unsigned char* wave_dst) { memcpy(wave_dst + (threadIdx.x & 63) * 16, gsrc, 16); }
static inline void glds16s(const void* sbase, unsigned voff, unsigned char* wave_dst) { memcpy(wave_dst + (threadIdx.x & 63) * 16, (const unsigned char*)sbase + voff, 16); }
#define WAIT_DMA_BAR() __syncthreads()
#define WAIT_DMA_BAR_KEEP() __syncthreads()
#else
#define LAS __attribute__((address_space(3)))
#define GAS __attribute__((address_space(1)))
#define WAVE_SYNC() asm volatile("s_waitcnt lgkmcnt(0)" ::: "memory")
#define VM_WAIT() asm volatile("s_waitcnt vmcnt(0)" ::: "memory")
typedef short v4i16_t __attribute__((ext_vector_type(4)));
__device__ __forceinline__ f32x16 mfma32(bf16x8 a, bf16x8 b, f32x16 c) { return __builtin_amdgcn_mfma_f32_32x32x16_bf16(a, b, c, 0, 0, 0); }
__device__ __forceinline__ f32x4 mfma16(bf16x8 a, bf16x8 b, f32x4 c) { return __builtin_amdgcn_mfma_f32_16x16x32_bf16(a, b, c, 0, 0, 0); }
__device__ __forceinline__ s16x4 ds_tr16(const LAS unsigned char* p) { return __builtin_bit_cast(s16x4, __builtin_amdgcn_ds_read_tr16_b64_v4i16((LAS v4i16_t*)p)); }
__device__ __forceinline__ float fexp2(float x) { return __builtin_amdgcn_exp2f(x); }
__device__ __forceinline__ float frcp(float x) { return __builtin_amdgcn_rcpf(x); }
__device__ __forceinline__ float frsq(float x) { return __builtin_amdgcn_rsqf(x); }
__device__ __forceinline__ int rfl(int x) { return __builtin_amdgcn_readfirstlane(x); }
#define OPAQUE(x) asm volatile("" : "+v"(x))
#define SETPRIO(n) __builtin_amdgcn_s_setprio(n)
#define BURN(x) do { float d_; asm volatile("v_exp_f32 %0, %1" : "=v"(d_) : "v"(x)); } while (0)
#define SCHED_FENCE() __builtin_amdgcn_sched_barrier(0)
__device__ __forceinline__ void glds16(const void* gsrc, LAS unsigned char* wave_dst) { unsigned keep; const unsigned d = (unsigned)__builtin_amdgcn_readfirstlane((int)(unsigned)(uintptr_t)wave_dst);
    asm volatile("s_mov_b32 %0, m0\n\ts_mov_b32 m0, %2\n\ts_nop 0\n\tglobal_load_lds_dwordx4 %1, off\n\ts_mov_b32 m0, %0" : "=&s"(keep) : "v"(gsrc), "s"(d) : "memory"); }
__device__ __forceinline__ void glds16s(const void* sbase, unsigned voff, LAS unsigned char* wave_dst) { unsigned keep; const unsigned d = (unsigned)__builtin_amdgcn_readfirstlane((int)(unsigned)(uintptr_t)wave_dst);
    asm volatile("s_mov_b32 %0, m0\n\ts_mov_b32 m0, %3\n\ts_nop 0\n\tglobal_load_lds_dwordx4 %1, %2\n\ts_mov_b32 m0, %0" : "=&s"(keep) : "v"(voff), "s"(sbase), "s"(d) : "memory"); }
#define WAIT_DMA_BAR() asm volatile("s_waitcnt vmcnt(0) lgkmcnt(0)\n\ts_barrier" ::: "memory")
#define WAIT_DMA_BAR_KEEP() asm volatile("s_waitcnt vmcnt(0)\n\ts_barrier" ::: "memory")
#endif

__device__ __forceinline__ unsigned f2bf(float f) { unsigned u = __builtin_bit_cast(unsigned, f); return (u + 0x7fffu + ((u >> 16) & 1u)) >> 16; }
#ifdef CPU_SIM
__device__ __forceinline__ unsigned pk2(float lo, float hi) { return f2bf(lo) | (f2bf(hi) << 16); }
#else
typedef __bf16 hw_bf16x2 __attribute__((ext_vector_type(2)));
__device__ __forceinline__ unsigned pk2(float lo, float hi) { const f32x2 v = {lo, hi}; return __builtin_bit_cast(unsigned, __builtin_convertvector(v, hw_bf16x2)); }
#endif
constexpr float F8_SH = 8.0f, F8_SW = 256.0f, F8_SM = 4.0f;
#ifdef CPU_SIM
static inline unsigned f2e4m3(float x) { unsigned sgn = x < 0 ? 0x80u : 0u; float ax = fabsf(x); if (!(ax == ax)) return sgn | 0x7fu; if (ax >= 448.f) return sgn | 0x7eu;
    if (ax < 0.015625f) { const int m = (int)rintf(ax * 512.f); return sgn | (unsigned)m; }
    int e; const float fr = frexpf(ax, &e); int m = (int)rintf(fr * 16.f); if (m == 16) { m = 8; ++e; } const int E = e - 1 + 7; if (E > 15 || (E == 15 && m - 8 > 6)) return sgn | 0x7eu; return sgn | (unsigned)(E << 3) | (unsigned)(m - 8); }
static inline float e4m32f(unsigned b) { const int E = (b >> 3) & 15, m = b & 7; float v = E == 0 ? ldexpf((float)m, -9) : ldexpf((float)(8 + m), E - 7 - 3); if (E == 15 && m == 7) v = NAN; return (b & 0x80u) ? -v : v; }
__device__ __forceinline__ unsigned pk4_f8(float a, float b, float c, float d) { return f2e4m3(a) | (f2e4m3(b) << 8) | (f2e4m3(c) << 16) | (f2e4m3(d) << 24); }
#else
__device__ __forceinline__ float f8clamp(float x) { return __builtin_amdgcn_fmed3f(x, -448.0f, 448.0f); }
__device__ __forceinline__ unsigned pk4_f8(float a, float b, float c, float d) { int w = 0; w = __builtin_amdgcn_cvt_pk_fp8_f32(f8clamp(a), f8clamp(b), w, false); w = __builtin_amdgcn_cvt_pk_fp8_f32(f8clamp(c), f8clamp(d), w, true); return (unsigned)w; }
#endif
__device__ __forceinline__ float bf2f(unsigned short b) { return __builtin_bit_cast(float, ((unsigned)b) << 16); }
__device__ __forceinline__ float bflo(unsigned w) { return __builtin_bit_cast(float, w << 16); }
__device__ __forceinline__ float bfhi(unsigned w) { return __builtin_bit_cast(float, w & 0xffff0000u); }
__device__ __forceinline__ float silu_f(float x) { return x * frcp(1.0f + __expf(-x)); }
__device__ __forceinline__ float sigm_f(float x) { return frcp(1.0f + __expf(-x)); }
__device__ __forceinline__ float gelu_f(float x) {
    const float t = frcp(fabsf(x) * 0.2316418882f + 1.0f);
    float q = t * 0.5307027145f + (-0.7265760135f); q = q * t + 0.7107068705f; q = q * t + (-0.142248368f); q = q * t + 0.127414796f; q = q * t;
    const float m = x * (q * fexp2(x * x * (-0.72134752044f)));
    return x < 0.f ? m : x - m;
}
#ifdef CPU_SIM
#define SHX(v, m, lane) __shfl_xor((v), (m))
#define SHI(v, src, lane) __shfl((v), (src))
#define SHC(v, srclane) __shfl((v), (srclane))
#define PARTNER32(v, lane) __shfl_xor((v), 32)
#else
__device__ __forceinline__ float shx_f(float v, int m, int lane) { return __builtin_bit_cast(float, __builtin_amdgcn_ds_bpermute((lane ^ m) << 2, __builtin_bit_cast(int, v))); }
__device__ __forceinline__ int shi_i(int v, int src) { return __builtin_amdgcn_ds_bpermute(src << 2, v); }
#define SHX(v, m, lane) shx_f((v), (m), (lane))
#define SHI(v, src, lane) shi_i((v), (src))
#define SHC(v, srclane) __builtin_bit_cast(float, __builtin_amdgcn_readlane(__builtin_bit_cast(int, (v)), (srclane)))
__device__ __forceinline__ float partner32_f(float v, int lane) { const unsigned u = __builtin_bit_cast(unsigned, v); auto r = __builtin_amdgcn_permlane32_swap(u, u, false, false); return __builtin_bit_cast(float, (lane & 32) ? r[0] : r[1]); }
#define PARTNER32(v, lane) partner32_f((v), (lane))
#endif
#ifdef CPU_SIM
static inline unsigned lds_add(unsigned* p, unsigned v) { const unsigned o = *p; *p = o + v; return o; }
#else
__device__ __forceinline__ unsigned lds_add(LAS unsigned* p, unsigned v) { return __hip_atomic_fetch_add(p, v, __ATOMIC_RELAXED, __HIP_MEMORY_SCOPE_WORKGROUP); }
#endif
__device__ __forceinline__ float wave_sum(float v, int lane) {
#pragma unroll
    for (int o = 1; o < 64; o <<= 1) v += SHX(v, o, lane);
    return v;
}
#undef N_LAUNCH_MODE
#define N_LAUNCH_MODE 0
namespace pg8 {
#ifdef CPU_SIM
constexpr int BM = 256, BK = 64, HALF = 128, NXCD = 8, WGM = 8;
static int g_cur_phase = -1; static unsigned long long g_fp8_mask = 0; static float g_fp8_sa = 8.f, g_fp8_sb = 256.f;
static inline float q_e4m3(float x) { if (!(x == x)) return x; float ax = fabsf(x); if (ax >= 448.f) return x < 0 ? -448.f : 448.f; if (ax < 0.015625f) { float r = rintf(ax * 512.f) / 512.f; return x < 0 ? -r : r; } int e; frexpf(ax, &e); float ulp = ldexpf(1.f, e - 1 - 3); float r = rintf(ax / ulp) * ulp; if (r > 448.f) r = 448.f; return x < 0 ? -r : r; }
static float* g_qtab[2] = {nullptr, nullptr}; static float g_qtab_s[2] = {0.f, 0.f};
static inline const float* fp8_tab(int which, float s) { if (g_qtab[which] && g_qtab_s[which] == s) return g_qtab[which]; if (!g_qtab[which]) g_qtab[which] = (float*)malloc(65536 * 4); for (int i = 0; i < 65536; ++i) g_qtab[which][i] = q_e4m3(bf2f((bf16_t)i) * s) / s; g_qtab_s[which] = s; return g_qtab[which]; }
struct Unit { int pm, pn; };
struct Gemm { const bf16_t* A; const bf16_t* Bt; int M, N, K; };
struct StaticOrder {
    int nM, nN, nwg, G, c;
    void init(int M, int N, int G_, int c_) { nM = M / BM; nN = N / BM; nwg = nM * nN; G = G_; c = c_; }
    bool next(int i, Unit& u) const {
        const long L = (long)i * G + c; if (L >= nwg) return false;
        int wgid = (int)L; { const int q = nwg / NXCD, r = nwg % NXCD, xcd = wgid % NXCD, off = wgid / NXCD; wgid = (xcd < r ? xcd * (q + 1) : r * (q + 1) + (xcd - r) * q) + off; }
        const int nig = WGM * nN, gid = wgid / nig, fm = gid * WGM, gsz = (nM - fm) < WGM ? (nM - fm) : WGM;
        u.pm = fm + ((wgid % nig) % gsz); u.pn = (wgid % nig) / gsz; return true;
    }
    void a_ready(const Unit&) const {}
    void done(const Unit&) const {}
};
template <class Epi, class Sched, bool ALIGN_EPI = false, bool SP2 = false>
inline void gemm_phase(unsigned char* lds, const Gemm g, const Sched& S, const Epi& E, const int tid_in) {
    const int tid = threadIdx.x, wid = tid >> 6, lane = tid & 63, wr = wid >> 2, wc = wid & 3, fr = lane & 15, fq = lane >> 4;
    Unit cur;
    const bool f8 = g_cur_phase >= 0 && ((g_fp8_mask >> g_cur_phase) & 1ull); const float* qa = f8 ? fp8_tab(0, g_fp8_sa) : nullptr; const float* qb = f8 ? fp8_tab(1, g_fp8_sb) : nullptr;
    for (int ui = 0; S.next(ui, cur); ++ui) {
        f32x4 acc[2][2][4][2];
        for (int ai = 0; ai < 2; ++ai) for (int bj = 0; bj < 2; ++bj) for (int m = 0; m < 4; ++m) for (int n = 0; n < 2; ++n) for (int j = 0; j < 4; ++j) {
            const int r = 256 * cur.pm + 128 * ai + 64 * wr + 16 * m + fr;
            const int c = 256 * cur.pn + 128 * bj + 32 * wc + (Epi::PERM ? (8 * fq + 4 * n + j) : (16 * n + 4 * fq + j));
            const bf16_t* a = g.A + (size_t)r * g.K; const bf16_t* b = g.Bt + (size_t)c * g.K; float s = 0.f;
            if (Epi::F8) { const unsigned char* a8 = (const unsigned char*)g.A + (size_t)r * g.K * 2; const unsigned char* b8 = (const unsigned char*)g.Bt + (size_t)c * g.K * 2; for (int k = 0; k < 2 * g.K; ++k) s += e4m32f(a8[k]) * e4m32f(b8[k]); } else
            if (f8) { for (int k = 0; k < g.K; ++k) s += qa[a[k]] * qb[b[k]]; } else
            for (int k = 0; k < g.K; ++k) s += bf2f(a[k]) * bf2f(b[k]);
            acc[ai][bj][m][n][j] = s;
        }
        E(acc, cur, wr, wc, fr, fq);
    }
    __syncthreads();
}
#else
#define PG8_LAS __attribute__((address_space(3)))
constexpr int BM = 256, BK = 64, HALF = 128, HTB = HALF * BK * 2  , STAGE_BYTES = 8 * HTB, NXCD = 8, WGM = 8;

__host__ __device__ __forceinline__ int lds_byte(int r, int c) { const int st = (r >> 4) * 2 + (c >> 5), rr = r & 15, cc = c & 31, ob = rr * 64 + cc * 2; return st * 1024 + (ob ^ (((ob >> 9) & 1) << 5)); }
__host__ __device__ __forceinline__ void stage_rc(int b, int& R, int& C) { const int st = b / 1024, sb = b % 1024, swz = sb ^ (((sb >> 9) & 1) << 5); R = (st >> 1) * 16 + swz / 64; C = (st & 1) * 32 + (swz % 64) / 2; }
__host__ __device__ __forceinline__ int perm32(int rho) { const int n = rho >> 4, i = rho & 15; return 8 * (i >> 2) + 4 * n + (i & 3); }

struct Unit { int pm, pn; };
struct Gemm { const bf16_t* A; const bf16_t* Bt; int M, N, K; };

struct StaticOrder {
    int nM, nN, nwg, G, c;
    __host__ __device__ void init(int M, int N, int G_, int c_) { nM = M / BM; nN = N / BM; nwg = nM * nN; G = G_; c = c_; }
    __host__ __device__ bool next(int i, Unit& u) const {
        const long L = (long)i * G + c; if (L >= nwg) return false;
        int wgid = (int)L; { const int q = nwg / NXCD, r = nwg % NXCD, xcd = wgid % NXCD, off = wgid / NXCD; wgid = (xcd < r ? xcd * (q + 1) : r * (q + 1) + (xcd - r) * q) + off; }
        const int nig = WGM * nN, gid = wgid / nig, fm = gid * WGM, gsz = (nM - fm) < WGM ? (nM - fm) : WGM;
        u.pm = fm + ((wgid % nig) % gsz); u.pn = (wgid % nig) / gsz; return true;
    }
    __device__ __forceinline__ void a_ready(const Unit&) const {}
    __device__ __forceinline__ void done(const Unit&) const {}
};

typedef int pg8_i32x4 __attribute__((ext_vector_type(4))); typedef int pg8_i32x8 __attribute__((ext_vector_type(8)));
__device__ __forceinline__ pg8_i32x8 pg8_cat(bf16x8 lo, bf16x8 hi) { const pg8_i32x4 a = __builtin_bit_cast(pg8_i32x4, lo), b = __builtin_bit_cast(pg8_i32x4, hi); return __builtin_shufflevector(a, b, 0, 1, 2, 3, 4, 5, 6, 7); }
template <class Epi, class Sched, bool ALIGN_EPI = false, bool SP2 = false>
__device__ __forceinline__ void gemm_phase(PG8_LAS unsigned char* lds, const Gemm g, const Sched& S, const Epi& E, const int tid_in) {
    const int tid = tid_in, wid = __builtin_amdgcn_readfirstlane(tid >> 6), lane = tid & 63, wr = wid >> 2, wc = wid & 3, fr = lane & 15, fq = lane >> 4;
    const int K = g.K, nt = K / BK;
    unsigned voffA[2], voffB[2];
#pragma unroll
    for (int i = 0; i < 2; ++i) { int R, C; stage_rc(tid * 16 + i * 8192, R, C); const int Rb = Epi::PERM ? ((R & ~31) + perm32(R & 31)) : R;
        voffA[i] = (unsigned)(R * K + C) * 2u; voffB[i] = (unsigned)(Rb * K + C) * 2u; }
    const size_t kstep = (size_t)(BK * 2);
    const size_t hstep = (size_t)HALF * K * 2;
    const size_t tstep = 2 * hstep;
    const unsigned ldsw = (unsigned)wid * 1024u;
    const int aoff = lds_byte(wr * 64 + fr, fq * 8), boff = lds_byte(wc * 32 + fr, fq * 8);
#define PG8_SA(b, h) (((b) * 2 + (h)) * HTB)
#define PG8_SB(b, h) ((4 + (b) * 2 + (h)) * HTB)
#define PG8_STAGE(bufoff, gbase, voff) do { _Pragma("unroll") for (int _i = 0; _i < 2; ++_i) \
        __builtin_amdgcn_global_load_lds((const unsigned*)((const char*)(gbase) + (voff)[_i]), (PG8_LAS unsigned*)(lds + (bufoff) + ldsw + _i * 8192), 16, 0, 0); } while (0)
#define PG8_LDA(dst, b, h) do { _Pragma("unroll") for (int m = 0; m < 4; ++m) _Pragma("unroll") for (int k = 0; k < 2; ++k) dst[m][k] = *(const PG8_LAS bf16x8*)(lds + PG8_SA(b, h) + aoff + m * 2048 + k * 1024); } while (0)
#define PG8_LDB(dst, b, h) do { _Pragma("unroll") for (int n = 0; n < 2; ++n) _Pragma("unroll") for (int k = 0; k < 2; ++k) dst[n][k] = *(const PG8_LAS bf16x8*)(lds + PG8_SB(b, h) + boff + n * 2048 + k * 1024); } while (0)
#define PG8_MMA(ai, bj, At, Bt) do { __builtin_amdgcn_s_setprio(1); if constexpr (Epi::F8) { _Pragma("unroll") for (int m = 0; m < 4; ++m) _Pragma("unroll") for (int n = 0; n < 2; ++n) \
        asm volatile("v_mfma_f32_16x16x128_f8f6f4 %0, %1, %2, %0" : "+v"(acc[ai][bj][m][n]) : "v"(pg8_cat(Bt[n][0], Bt[n][1])), "v"(pg8_cat(At[m][0], At[m][1]))); } else { \
        _Pragma("unroll") for (int m = 0; m < 4; ++m) _Pragma("unroll") for (int n = 0; n < 2; ++n) _Pragma("unroll") for (int k = 0; k < 2; ++k) \
        acc[ai][bj][m][n] = __builtin_amdgcn_mfma_f32_16x16x32_bf16(Bt[n][k], At[m][k], acc[ai][bj][m][n], 0, 0, 0); } __builtin_amdgcn_s_setprio(0); } while (0)
#define PG8_WAIT_V(n) asm volatile("s_waitcnt vmcnt(" #n ")" ::: "memory")
#define PG8_WAIT_L(n) asm volatile("s_waitcnt lgkmcnt(" #n ")" ::: "memory")
#define PG8_BAR __builtin_amdgcn_s_barrier()
#define PG8_SCHED __builtin_amdgcn_sched_barrier(0)
    Unit cur, nxt; int ui = 0;
    if (!S.next(0, cur)) return;
    f32x4 acc[2][2][4][2];
#pragma unroll
    for (int a = 0; a < 2; ++a)
#pragma unroll
        for (int b = 0; b < 2; ++b)
#pragma unroll
            for (int m = 0; m < 4; ++m)
#pragma unroll
                for (int n = 0; n < 2; ++n) acc[a][b][m][n] = (f32x4){0.f, 0.f, 0.f, 0.f};
    bf16x8 At[4][2], B0[2][2], B1[2][2];
    const char* cA = (const char*)g.A + (size_t)cur.pm * tstep; const char* cB = (const char*)g.Bt + (size_t)cur.pn * tstep;
    S.a_ready(cur);
    if constexpr (SP2) {
        PG8_STAGE(PG8_SB(0, 0), cB, voffB); PG8_STAGE(PG8_SB(0, 1), cB + hstep, voffB); PG8_STAGE(PG8_SA(0, 0), cA, voffA); PG8_STAGE(PG8_SA(0, 1), cA + hstep, voffA);
        if (wr == 1) PG8_BAR;
        PG8_WAIT_V(2); PG8_BAR;
        PG8_STAGE(PG8_SB(1, 0), cB + kstep, voffB); PG8_STAGE(PG8_SA(1, 0), cA + kstep, voffA); PG8_STAGE(PG8_SB(1, 1), cB + hstep + kstep, voffB);
        PG8_WAIT_V(6); PG8_BAR;
    } else {
        PG8_STAGE(PG8_SB(0, 0), cB, voffB); PG8_STAGE(PG8_SA(0, 0), cA, voffA); PG8_STAGE(PG8_SB(0, 1), cB + hstep, voffB); PG8_STAGE(PG8_SA(0, 1), cA + hstep, voffA);
        if (wr == 1) PG8_BAR;
        PG8_WAIT_V(4); PG8_BAR;
        PG8_STAGE(PG8_SB(1, 0), cB + kstep, voffB); PG8_STAGE(PG8_SA(1, 0), cA + kstep, voffA); PG8_STAGE(PG8_SB(1, 1), cB + hstep + kstep, voffB);
        PG8_WAIT_V(6); PG8_BAR;
    }
    for (;;) {
        const bool has_next = S.next(ui + 1, nxt);
        const char* nA = has_next ? (const char*)g.A + (size_t)nxt.pm * tstep : cA; const char* nB = has_next ? (const char*)g.Bt + (size_t)nxt.pn * tstep : cB;
        _Pragma("nounroll") for (int t = 0; t < nt; t += 2) {
            const bool last = (t == nt - 2);
            const char* a1 = cA + (size_t)(t + 1) * kstep;
            const char* a2 = last ? nA : cA + (size_t)(t + 2) * kstep; const char* b2 = last ? nB : cB + (size_t)(t + 2) * kstep;
            const char* a3 = a2 + kstep; const char* b3 = b2 + kstep;
            if (last && has_next) S.a_ready(nxt);
            if constexpr (SP2) {
            PG8_LDB(B0, 0, 0); PG8_LDB(B1, 0, 1); PG8_SCHED; PG8_LDA(At, 0, 0); PG8_STAGE(PG8_SA(1, 1), a1 + hstep, voffA);
            PG8_WAIT_V(8); PG8_WAIT_L(0); PG8_BAR; PG8_MMA(0, 0, At, B0); PG8_MMA(0, 1, At, B1); PG8_BAR; PG8_SCHED;
            PG8_LDA(At, 0, 1); PG8_STAGE(PG8_SB(0, 0), b2, voffB); PG8_STAGE(PG8_SB(0, 1), b2 + hstep, voffB); PG8_STAGE(PG8_SA(0, 0), a2, voffA);
            PG8_WAIT_V(8); PG8_WAIT_L(0); PG8_BAR; PG8_MMA(1, 0, At, B0); PG8_MMA(1, 1, At, B1); PG8_BAR; PG8_SCHED;
            PG8_LDB(B0, 1, 0); PG8_LDB(B1, 1, 1); PG8_SCHED; PG8_LDA(At, 1, 0); PG8_STAGE(PG8_SA(0, 1), a2 + hstep, voffA);
            PG8_WAIT_V(8); PG8_WAIT_L(0); PG8_BAR; PG8_MMA(0, 0, At, B0); PG8_MMA(0, 1, At, B1); PG8_BAR; PG8_SCHED;
            PG8_LDA(At, 1, 1); PG8_STAGE(PG8_SB(1, 0), b3, voffB); PG8_STAGE(PG8_SB(1, 1), b3 + hstep, voffB); PG8_STAGE(PG8_SA(1, 0), a3, voffA);
            PG8_WAIT_V(8); PG8_WAIT_L(0); PG8_BAR; PG8_MMA(1, 0, At, B0); PG8_MMA(1, 1, At, B1); PG8_BAR; PG8_SCHED;
            } else {
            PG8_LDB(B0, 0, 0); PG8_SCHED; PG8_LDA(At, 0, 0); PG8_STAGE(PG8_SA(1, 1), a1 + hstep, voffA);
            PG8_WAIT_L(8); PG8_BAR; PG8_WAIT_L(0); PG8_MMA(0, 0, At, B0); PG8_BAR; PG8_SCHED;
            PG8_LDB(B1, 0, 1); PG8_STAGE(PG8_SB(0, 0), b2, voffB);
            PG8_BAR; PG8_WAIT_L(0); PG8_MMA(0, 1, At, B1); PG8_BAR;
            PG8_LDA(At, 0, 1); PG8_STAGE(PG8_SA(0, 0), a2, voffA);
            PG8_BAR; PG8_WAIT_L(0); PG8_MMA(1, 0, At, B0); PG8_BAR; PG8_SCHED;
            PG8_STAGE(PG8_SB(0, 1), b2 + hstep, voffB);
            PG8_WAIT_V(6); PG8_BAR; PG8_MMA(1, 1, At, B1); PG8_BAR;
            PG8_LDB(B0, 1, 0); PG8_SCHED; PG8_LDA(At, 1, 0); PG8_STAGE(PG8_SA(0, 1), a2 + hstep, voffA);
            PG8_WAIT_L(8); PG8_BAR; PG8_WAIT_L(0); PG8_MMA(0, 0, At, B0); PG8_BAR; PG8_SCHED;
            PG8_LDB(B1, 1, 1); PG8_STAGE(PG8_SB(1, 0), b3, voffB);
            PG8_BAR; PG8_WAIT_L(0); PG8_MMA(0, 1, At, B1); PG8_BAR;
            PG8_LDA(At, 1, 1); PG8_STAGE(PG8_SA(1, 0), a3, voffA);
            PG8_BAR; PG8_WAIT_L(0); PG8_MMA(1, 0, At, B0); PG8_BAR; PG8_SCHED;
            PG8_STAGE(PG8_SB(1, 1), b3 + hstep, voffB);
            PG8_WAIT_V(6); PG8_BAR; PG8_MMA(1, 1, At, B1); PG8_BAR;
            }
        }
        if constexpr (Epi::F8) asm volatile("s_nop 15\n\ts_nop 15" ::: "memory");
        if constexpr (ALIGN_EPI) { if (wr == 0) PG8_BAR; }
        if constexpr (!Epi::AFTER_DRAIN) { E(acc, cur, wr, wc, fr, fq); S.done(cur); }
        if (!has_next) break;
#pragma unroll
        for (int a = 0; a < 2; ++a)
#pragma unroll
            for (int b = 0; b < 2; ++b)
#pragma unroll
                for (int m = 0; m < 4; ++m)
#pragma unroll
                    for (int n = 0; n < 2; ++n) acc[a][b][m][n] = (f32x4){0.f, 0.f, 0.f, 0.f};
        cur = nxt; cA = nA; cB = nB; ++ui;
        if constexpr (ALIGN_EPI) { if (wr == 1) PG8_BAR; }
    }
    PG8_WAIT_V(0);
    if constexpr (!ALIGN_EPI) { if (wr == 0) PG8_BAR; }
    PG8_BAR;
    if constexpr (Epi::AFTER_DRAIN) { E.fused(acc, cur, wr, wc, fr, fq, lds, wid, lane); S.done(cur); }
#undef PG8_SA
#undef PG8_SB
#undef PG8_STAGE
#undef PG8_LDA
#undef PG8_LDB
#undef PG8_MMA
#undef PG8_WAIT_V
#undef PG8_WAIT_L
#undef PG8_BAR
#undef PG8_SCHED
}
#endif
}

namespace pg8 {
struct EpiStoreBf16 {
    static constexpr bool PERM = true, AFTER_DRAIN = false, F8 = false;
    bf16_t* O; int ldc; int ntn;
    __device__ __forceinline__ void operator()(const f32x4 (&acc)[2][2][4][2], const Unit& u, int wr, int wc, int fr, int fq) const {
        const int row0 = u.pm * BM + wr * 64 + fr, col0 = (u.pn % ntn) * BM + wc * 32 + 8 * fq;
#pragma unroll
        for (int ai = 0; ai < 2; ++ai)
#pragma unroll
            for (int m = 0; m < 4; ++m) { bf16_t* rowp = O + (size_t)(row0 + ai * HALF + m * 16) * ldc + col0;
#pragma unroll
                for (int bj = 0; bj < 2; ++bj) { const f32x4 v0 = acc[ai][bj][m][0], v1 = acc[ai][bj][m][1];
                    u32x4 w; w.x = pk2(v0[0], v0[1]); w.y = pk2(v0[2], v0[3]); w.z = pk2(v1[0], v1[1]); w.w = pk2(v1[2], v1[3]);
                    *(u32x4*)(rowp + bj * HALF) = w; } }
    }
};
struct EpiSwiglu {
    static constexpr bool PERM = true, AFTER_DRAIN = false, F8 = false;
    bf16_t* O; int ldc; int ntn;
    __device__ __forceinline__ void operator()(const f32x4 (&acc)[2][2][4][2], const Unit& u, int wr, int wc, int fr, int fq) const {
        const int row0 = u.pm * BM + wr * 64 + fr, col0 = (u.pn % ntn) * HALF + wc * 32 + 8 * fq;
#pragma unroll
        for (int ai = 0; ai < 2; ++ai)
#pragma unroll
            for (int m = 0; m < 4; ++m) { bf16_t* rowp = O + (size_t)(row0 + ai * HALF + m * 16) * ldc + col0;
                float hv[8];
#pragma unroll
                for (int n = 0; n < 2; ++n)
#pragma unroll
                    for (int q = 0; q < 4; ++q) { const float g = acc[ai][0][m][n][q], up = acc[ai][1][m][n][q]; hv[n * 4 + q] = silu_f(g) * up; }
                u32x4 w; w.x = pk2(hv[0], hv[1]); w.y = pk2(hv[2], hv[3]); w.z = pk2(hv[4], hv[5]); w.w = pk2(hv[6], hv[7]);
                *(u32x4*)rowp = w; }
    }
};
struct EpiStoreBf16S {
    static constexpr bool PERM = true, AFTER_DRAIN = false, F8 = true;
    bf16_t* O; int ldc; int ntn; float scl;
    __device__ __forceinline__ void operator()(const f32x4 (&acc)[2][2][4][2], const Unit& u, int wr, int wc, int fr, int fq) const {
        const int row0 = u.pm * BM + wr * 64 + fr, col0 = (u.pn % ntn) * BM + wc * 32 + 8 * fq;
#pragma unroll
        for (int ai = 0; ai < 2; ++ai)
#pragma unroll
            for (int m = 0; m < 4; ++m) { bf16_t* rowp = O + (size_t)(row0 + ai * HALF + m * 16) * ldc + col0;
#pragma unroll
                for (int bj = 0; bj < 2; ++bj) { const f32x4 v0 = acc[ai][bj][m][0] * scl, v1 = acc[ai][bj][m][1] * scl;
                    u32x4 w; w.x = pk2(v0[0], v0[1]); w.y = pk2(v0[2], v0[3]); w.z = pk2(v1[0], v1[1]); w.w = pk2(v1[2], v1[3]);
                    *(u32x4*)(rowp + bj * HALF) = w; } }
    }
};
struct EpiSwigluF8 {
    static constexpr bool PERM = true, AFTER_DRAIN = false, F8 = true;
    unsigned char* O; int ldc; int ntn; float scl;
    __device__ __forceinline__ void operator()(const f32x4 (&acc)[2][2][4][2], const Unit& u, int wr, int wc, int fr, int fq) const {
        const int row0 = u.pm * BM + wr * 64 + fr, col0 = (u.pn % ntn) * HALF + wc * 32 + 8 * fq;
#pragma unroll
        for (int ai = 0; ai < 2; ++ai)
#pragma unroll
            for (int m = 0; m < 4; ++m) { unsigned char* rowp = O + (size_t)(row0 + ai * HALF + m * 16) * ldc + col0;
                float hv[8];
#pragma unroll
                for (int n = 0; n < 2; ++n)
#pragma unroll
                    for (int q = 0; q < 4; ++q) { const float g = acc[ai][0][m][n][q] * scl, up = acc[ai][1][m][n][q] * (scl * F8_SM); hv[n * 4 + q] = silu_f(g) * up; }
                u32x2 w; w.x = pk4_f8(hv[0], hv[1], hv[2], hv[3]); w.y = pk4_f8(hv[4], hv[5], hv[6], hv[7]);
                *(u32x2*)rowp = w; }
    }
};
struct EpiResid {
    static constexpr bool PERM = false, AFTER_DRAIN = false, F8 = false;
    const float* Xin; float* Xout; const float* gate_lat; const float* gate_ctx;
    __device__ __forceinline__ void operator()(const f32x4 (&acc)[2][2][4][2], const Unit& u, int wr, int wc, int fr, int fq) const {
        const float* gp = (u.pm == 0) ? gate_ctx : gate_lat;
        const int row0 = u.pm * BM + wr * 64 + fr, col0 = u.pn * BM + wc * 32 + 4 * fq;
#pragma unroll
        for (int bj = 0; bj < 2; ++bj)
#pragma unroll
            for (int n = 0; n < 2; ++n) { const int col = col0 + bj * HALF + n * 16; const f32x4 gv = *(const f32x4*)(gp + col);
#pragma unroll
                for (int ai = 0; ai < 2; ++ai)
#pragma unroll
                    for (int m = 0; m < 4; ++m) { const size_t o = (size_t)(row0 + ai * HALF + m * 16) * D + col; *(f32x4*)(Xout + o) = *(const f32x4*)(Xin + o) + gv * acc[ai][bj][m][n]; } }
    }
};
struct EpiQkvRope {
    static constexpr bool PERM = true, AFTER_DRAIN = false, F8 = false;
    bf16_t* QR; bf16_t* KR; bf16_t* P; const float* tab; unsigned* kb;
    __device__ __forceinline__ void operator()(const f32x4 (&acc)[2][2][4][2], const Unit& u, int wr, int wc, int fr, int fq) const {
        const int row0 = u.pm * BM + wr * 64 + fr, lane = fq * 16 + fr;
        if (u.pn >= 8) {
            const int col0 = u.pn * BM + wc * 32 + 8 * fq;
#pragma unroll
            for (int ai = 0; ai < 2; ++ai)
#pragma unroll
                for (int m = 0; m < 4; ++m) { bf16_t* rowp = P + (size_t)(row0 + ai * HALF + m * 16) * DQKV + col0;
#pragma unroll
                    for (int bj = 0; bj < 2; ++bj) { const f32x4 v0 = acc[ai][bj][m][0], v1 = acc[ai][bj][m][1];
                        u32x4 w; w.x = pk2(v0[0], v0[1]); w.y = pk2(v0[2], v0[3]); w.z = pk2(v1[0], v1[1]); w.w = pk2(v1[2], v1[3]);
                        *(u32x4*)(rowp + bj * HALF) = w; } }
            return;
        }
        const bool isq = u.pn < 4; bf16_t* dst = isq ? QR : KR; const float scl = isq ? QSCALE : 1.0f;
        const int axis = wc & 1, i0 = 8 * (fq & 1); const float sgn = (fq & 2) ? 1.0f : -1.0f;
        float kmx[2] = {0.f, 0.f};
#pragma unroll
        for (int ai = 0; ai < 2; ++ai)
#pragma unroll
            for (int m = 0; m < 4; ++m) { const int row = row0 + ai * HALF + m * 16; const int pa = axis ? (row % GRID_W) : (row / GRID_W);
                const f32x4* tp = (const f32x4*)(tab + (size_t)(pa * 16 + i0) * 2); const f32x4 t0 = tp[0], t1 = tp[1], t2 = tp[2], t3 = tp[3];
                const float cs[8] = {t0[0], t0[2], t1[0], t1[2], t2[0], t2[2], t3[0], t3[2]}, sn[8] = {t0[1], t0[3], t1[1], t1[3], t2[1], t2[3], t3[1], t3[3]};
#pragma unroll
                for (int bj = 0; bj < 2; ++bj) { float o[8]; float ssq = 0.f;
#pragma unroll
                    for (int k = 0; k < 8; ++k) { const float own = acc[ai][bj][m][k >> 2][k & 3]; const float par = PARTNER32(own, lane); o[k] = (own * cs[k] + sgn * par * sn[k]) * scl; }
                    u32x4 w; w.x = pk2(o[0], o[1]); w.y = pk2(o[2], o[3]); w.z = pk2(o[4], o[5]); w.w = pk2(o[6], o[7]);
                    *(u32x4*)(dst + (size_t)(CTX + row) * D + (u.pn & 3) * BM + bj * HALF + wc * 32 + 8 * fq) = w;
                    if (!isq) {
#pragma unroll
                        for (int e = 0; e < 4; ++e) ssq += bflo(w[e]) * bflo(w[e]) + bfhi(w[e]) * bfhi(w[e]);
                        kmx[bj] = fmaxf(kmx[bj], ssq); } } }
        if (!isq) {
#pragma unroll
            for (int bj = 0; bj < 2; ++bj) { float v = kmx[bj];
#pragma unroll
                for (int o2 = 1; o2 < 16; o2 <<= 1) v = fmaxf(v, SHX(v, o2, lane));
                const int head = (u.pn & 3) * 2 + bj, map = wc >> 1, part = (wc & 1) * 4 + fq;
                if (fr == 0) atomicMax(kb + (head * 2 + map) * 8 + part, __builtin_bit_cast(unsigned, v)); }
        }
    }
};
struct MoeOrder {
    const int* tab; int ntn, G, c;
    __device__ __forceinline__ bool next(int i, Unit& u) const {
        const int ntr = tab[0]; const long L = (long)i * G + c; if (L >= (long)ntr * ntn) return false;
        const int rt = (int)(L / ntn), ct = (int)(L % ntn); u.pm = rt; u.pn = tab[16 + rt] * ntn + ct; return true;
    }
    __device__ __forceinline__ void a_ready(const Unit&) const {}
    __device__ __forceinline__ void done(const Unit&) const {}
};
}

#ifndef CPU_SIM
#define XB_TMO      128
#define XB_XCNT(j)  (256  + 64 * (j))
#define XB_XSUB(j)  (1280 + 64 * (j))
#define XB_XGEN(j)  (2304 + 64 * (j))
#define XB_TOP      3328
#define XB_TOPGEN   3392
#define XCD_BAR_WORDS 3456
#define XB_SPIN_CAP (1u << 18)
__device__ __forceinline__ unsigned xb_ld(unsigned* p)              { return __hip_atomic_load(p, __ATOMIC_RELAXED, __HIP_MEMORY_SCOPE_AGENT); }
__device__ __forceinline__ unsigned xb_add(unsigned* p, unsigned v) { return __hip_atomic_fetch_add(p, v, __ATOMIC_RELAXED, __HIP_MEMORY_SCOPE_AGENT); }
__device__ __forceinline__ unsigned xb_xcc_id() { return (unsigned)__builtin_amdgcn_s_getreg((3 << 11) | 20) & 0xFu; }
#define XB_SPIN(cond, bar) do { unsigned _sp = 0; while (cond) { __builtin_amdgcn_s_sleep(1); \
    if ((++_sp & 255u) == 0u) { if (xb_ld(&(bar)[XB_TMO])) break; if (_sp > XB_SPIN_CAP) { atomicAdd(&(bar)[XB_TMO], 1u); break; } } } } while (0)
struct XcdBarrier { unsigned* bar; unsigned x; volatile LAS unsigned* st; };
__device__ __forceinline__ XcdBarrier xcd_barrier_post(unsigned* bar, volatile LAS unsigned* st, int tid) {
    XcdBarrier b; b.bar = bar; b.x = xb_xcc_id(); b.st = st;
    if (tid == 0) (void)xb_add(&bar[XB_XCNT(b.x)], 1u);
    return b;
}
__device__ __forceinline__ void xcd_barrier_complete(unsigned* bar, unsigned x, unsigned& nloc, unsigned& nx) {
    const unsigned G = gridDim.x * gridDim.y * gridDim.z;
    unsigned sum, cnt, mine, sp = 0u;
    for (;;) {
        sum = 0u; cnt = 0u; mine = 0u;
#pragma unroll
        for (unsigned j = 0; j < 16; ++j) { const unsigned c = xb_ld(&bar[XB_XCNT(j)]); sum += c; cnt += (c > 0u) ? 1u : 0u; mine = (j == x) ? c : mine; }
        if (sum == G) break;
        __builtin_amdgcn_s_sleep(1);
        if ((++sp & 255u) == 0u) { if (xb_ld(&bar[XB_TMO])) break; if (sp > XB_SPIN_CAP) { atomicAdd(&bar[XB_TMO], 1u); break; } }
    }
    nloc = mine > 0u ? mine : 1u; nx = cnt > 0u ? cnt : 1u;
}
__device__ __forceinline__ void xcd_barrier(const XcdBarrier& b, int tid) {
    asm volatile("s_waitcnt vmcnt(0)" ::: "memory");
    __syncthreads();
    if (tid == 0) {
        unsigned* bar = b.bar;
        __builtin_amdgcn_s_waitcnt(0);
        unsigned nloc = b.st[0], nx = b.st[1];
        if (nloc == 0u) { xcd_barrier_complete(bar, b.x, nloc, nx); b.st[0] = nloc; b.st[1] = nx; }
        const unsigned old = xb_add(&bar[XB_XSUB(b.x)], 1u);
        const unsigned gen = old / nloc;
        if (old + 1u == (gen + 1u) * nloc) {
            __builtin_amdgcn_fence(__ATOMIC_RELEASE, "agent");
            asm volatile("s_waitcnt vmcnt(0)" ::: "memory");
            const unsigned og = xb_add(&bar[XB_TOP], 1u);
            const unsigned tg = og / nx;
            if (og + 1u == (tg + 1u) * nx) xb_add(&bar[XB_TOPGEN], 1u);
            else XB_SPIN(xb_ld(&bar[XB_TOPGEN]) == tg, bar);
            __builtin_amdgcn_fence(__ATOMIC_ACQUIRE, "agent");
            xb_add(&bar[XB_XGEN(b.x)], 1u);
            asm volatile("s_waitcnt vmcnt(0)" ::: "memory");
        } else {
            XB_SPIN(xb_ld(&bar[XB_XGEN(b.x)]) == gen, bar);
            __builtin_amdgcn_fence(__ATOMIC_ACQUIRE, "agent");
            asm volatile("s_waitcnt vmcnt(0)" ::: "memory");
        }
    }
    __syncthreads();
}
#endif

struct KArgs { const float* in[26]; float* out; unsigned char* ws; int ph_lo, ph_hi; int variant; };
#ifdef CPU_SIM
typedef const KArgs* KArgP;
#define TIDX(a) ((a).tid)
#define FRESH_TID(a) ((int)threadIdx.x)
#else
typedef const __attribute__((address_space(4))) KArgs* KArgP;
#define TIDX(a) ((a).tid)
#define FRESH_TID(a) ({ unsigned z_ = 0u; asm volatile("" : "+s"(z_)); (a).wv * 64 + (int)__builtin_amdgcn_mbcnt_hi(~0u, __builtin_amdgcn_mbcnt_lo(~0u, z_)); })
#endif
struct KCtx { KArgP p; int wv, tid, bx, G; LAS unsigned char* L; };
enum { I_X = 0, I_C, I_CTX, I_CCTX, I_MODW, I_MODB, I_HGLB, I_EVWIN, I_HGNG, I_SGLNG, I_SGLNB, I_SGW, I_SGB, I_EVWOUT, I_DAQKV, I_DALAM, I_DASUBG, I_DAWOUT,
       I_FFG, I_FFU, I_FFD, I_MOER, I_MOEG, I_MOEU, I_MOED, I_FING };

#define WSP(T_, off) ((T_*)(a.p->ws + (off)))

__device__ __forceinline__ void tr_item(const float* W, int N, int K, bf16_t* WT, int k0, int n0, int drow0, LAS float* scr, int lane) {
    float wv[64];
#pragma unroll
    for (int kk = 0; kk < 64; ++kk) wv[kk] = W[(size_t)(k0 + kk) * N + n0 + lane];
#pragma unroll
    for (int kk = 0; kk < 64; ++kk) scr[kk * 65 + lane] = wv[kk];
    WAVE_SYNC();
    const int c = lane & 7;
#pragma unroll
    for (int j = 0; j < 8; ++j) { const int n = (lane >> 3) + 8 * j; const LAS float* s = scr + (8 * c) * 65 + n;
        u32x4 o; o.x = pk2(s[0 * 65], s[1 * 65]); o.y = pk2(s[2 * 65], s[3 * 65]); o.z = pk2(s[4 * 65], s[5 * 65]); o.w = pk2(s[6 * 65], s[7 * 65]);
        *(u32x4*)(WT + (size_t)(drow0 + n) * K + k0 + 8 * c) = o; }
    WAVE_SYNC();
}
__device__ __forceinline__ void tr_item8(const float* W, int N, int K, unsigned char* WT, int k0, int n0, int drow0, LAS float* scr, int lane) {
    float wv[64];
#pragma unroll
    for (int kk = 0; kk < 64; ++kk) wv[kk] = W[(size_t)(k0 + kk) * N + n0 + lane];
#pragma unroll
    for (int kk = 0; kk < 64; ++kk) scr[kk * 65 + lane] = wv[kk];
    WAVE_SYNC();
    const int c = lane & 3;
#pragma unroll
    for (int j = 0; j < 4; ++j) { const int n = (lane >> 2) + 16 * j; const LAS float* s = scr + (16 * c) * 65 + n;
        u32x4 o; o.x = pk4_f8(s[0 * 65] * F8_SW, s[1 * 65] * F8_SW, s[2 * 65] * F8_SW, s[3 * 65] * F8_SW); o.y = pk4_f8(s[4 * 65] * F8_SW, s[5 * 65] * F8_SW, s[6 * 65] * F8_SW, s[7 * 65] * F8_SW);
        o.z = pk4_f8(s[8 * 65] * F8_SW, s[9 * 65] * F8_SW, s[10 * 65] * F8_SW, s[11 * 65] * F8_SW); o.w = pk4_f8(s[12 * 65] * F8_SW, s[13 * 65] * F8_SW, s[14 * 65] * F8_SW, s[15 * 65] * F8_SW);
        *(u32x4*)(WT + (size_t)(drow0 + n) * K + k0 + 16 * c) = o; }
    WAVE_SYNC();
}
template <int MODE, bool F8 = false>
__device__ __forceinline__ void tr_mat(const float* W, int K, int N, bf16_t* WT, LAS float* scr, int gw, int NGW, int lane, int& itbase) {
    const int nblk = N / 64, nitems = (K / 64) * nblk;
    for (int it = ((gw - itbase) % NGW + NGW) % NGW; it < nitems; it += NGW) {
        const int kb = it / nblk, nb = it % nblk, n0 = nb * 64;
        const int drow0 = MODE == 0 ? n0 : ((n0 >> 7) * 256 + (n0 & 127) + (MODE == 2 ? 128 : 0));
        if (F8) tr_item8(W, N, K, (unsigned char*)WT, kb * 64, n0, drow0, scr, lane); else tr_item(W, N, K, WT, kb * 64, n0, drow0, scr, lane);
    }
    itbase = (itbase + nitems) % NGW;
}
__device__ __forceinline__ void moe_weights(const KCtx& a, int j, LAS unsigned char* lds, int& itbase) {
    const int tid = TIDX(a), lane = tid & 63, wave = rfl(tid >> 6), gw = a.bx * NWAVES + wave, NGW = a.G * NWAVES;
    LAS float* scr = (LAS float*)(lds + wave * 16896);
    for (int e = 0; e < NEXP; ++e) {
        bf16_t* gu = (bf16_t*)(WSP(unsigned char, WS_MGU) + (size_t)e * 2 * EFF * D); bf16_t* dn = (bf16_t*)(WSP(unsigned char, WS_MDN) + (size_t)e * D * EFF);
        tr_mat<1, true>(a.p->in[I_MOEG] + (size_t)(j * NEXP + e) * D * EFF, D, EFF, gu, scr, gw, NGW, lane, itbase);
        tr_mat<2, true>(a.p->in[I_MOEU] + (size_t)(j * NEXP + e) * D * EFF, D, EFF, gu, scr, gw, NGW, lane, itbase);
        tr_mat<0, true>(a.p->in[I_MOED] + (size_t)(j * NEXP + e) * EFF * D, EFF, D, dn, scr, gw, NGW, lane, itbase);
    }
}
__device__ __forceinline__ void ph_prologue(const KCtx& a, LAS unsigned char* lds) {
    const int tid = TIDX(a), lane = tid & 63, wave = rfl(tid >> 6), gw = a.bx * NWAVES + wave, NGW = a.G * NWAVES;
    LAS float* sv = (LAS float*)lds;
    for (int i = tid; i < 2048; i += NTHR) sv[i] = silu_f(i < 1024 ? a.p->in[I_C][i] : a.p->in[I_CCTX][i - 1024]);
    __syncthreads();
    float* modv = WSP(float, WS_SMALL + SM_MODV);
    LAS float* part = (LAS float*)(lds + 8192);
    for (int it = a.bx; it < 4 * 96; it += a.G) {
        const int l = it / 96, n = (it % 96) * 64 + lane; const float* W = a.p->in[I_MODW] + (size_t)l * D * 6144 + (size_t)(wave * 128) * 6144 + n; float a0 = 0.f, a1 = 0.f;
#pragma unroll 16
        for (int k = 0; k < 128; ++k) { const float w = W[(size_t)k * 6144]; a0 += sv[wave * 128 + k] * w; a1 += sv[1024 + wave * 128 + k] * w; }
        part[(wave * 2 + 0) * 64 + lane] = a0; part[(wave * 2 + 1) * 64 + lane] = a1;
        __syncthreads();
        if (wave < 2) { float sacc = 0.f;
#pragma unroll
            for (int w = 0; w < 8; ++w) sacc += part[(w * 2 + wave) * 64 + lane];
            modv[(l * 2 + wave) * 6144 + n] = sacc + a.p->in[I_MODB][l * 6144 + n]; }
        __syncthreads();
    }
    __syncthreads();
    { const int gt0 = a.bx * NTHR + tid; if (gt0 < 256 * 16) { const int pos = gt0 >> 4, i = gt0 & 15; const float ang = (float)pos * expf(-(float)(2 * i) * (1.0f / 32.0f) * 9.210340371976184f);
        float* tb = WSP(float, WS_SMALL + SM_ROPE) + gt0 * 2; tb[0] = cosf(ang); tb[1] = sinf(ang); } }
    if (a.bx == 0 && wave < 2) {
        const float* lm = a.p->in[I_DALAM] + wave * 256; const float s1 = wave_sum(lm[lane] * lm[64 + lane], lane), s2 = wave_sum(lm[128 + lane] * lm[192 + lane], lane);
        const float lam_init = 0.8f - 0.6f * expf(-0.3f * (float)(2 * wave + 1));
        if (lane == 0) WSP(float, WS_SMALL + SM_LAMF)[wave] = expf(s1) - expf(s2) + lam_init;
    }
    { const int gt = a.bx * NTHR + tid, NGT = a.G * NTHR;
      bf16_t* sgw = WSP(bf16_t, WS_SGW);
      for (int i = gt; i < 2 * 4 * 128 * 128; i += NGT) sgw[i] = (bf16_t)f2bf(a.p->in[I_SGW][i]); }
    LAS float* scr = (LAS float*)(lds + wave * 16896);
    int itbase = 0;
    for (int j = 0; j < 2; ++j) {
        tr_mat<0>(a.p->in[I_EVWIN] + (size_t)j * D * EVEN_IN, D, EVEN_IN, WSP(bf16_t, WS_WIN + j * SZ_WIN), scr, gw, NGW, lane, itbase);
        tr_mat<0>(a.p->in[I_EVWOUT] + (size_t)j * D * D, D, D, WSP(bf16_t, WS_WEO + j * SZ_WSQ), scr, gw, NGW, lane, itbase);
        tr_mat<1>(a.p->in[I_FFG] + (size_t)j * D * DFF, D, DFF, WSP(bf16_t, WS_WGU + j * SZ_WGU), scr, gw, NGW, lane, itbase);
        tr_mat<2>(a.p->in[I_FFU] + (size_t)j * D * DFF, D, DFF, WSP(bf16_t, WS_WGU + j * SZ_WGU), scr, gw, NGW, lane, itbase);
        tr_mat<0>(a.p->in[I_FFD] + (size_t)j * DFF * D, DFF, D, WSP(bf16_t, WS_WDN + j * SZ_WDN), scr, gw, NGW, lane, itbase);
        tr_mat<0>(a.p->in[I_DAQKV] + (size_t)j * D * DQKV, D, DQKV, WSP(bf16_t, WS_WQKV + j * SZ_WQKV), scr, gw, NGW, lane, itbase);
        tr_mat<0>(a.p->in[I_DAWOUT] + (size_t)j * D * D, D, D, WSP(bf16_t, WS_WAO + j * SZ_WSQ), scr, gw, NGW, lane, itbase);
    }
    moe_weights(a, 0, lds, itbase);
}

template <bool COMBINE, bool ROUTER, bool FINAL, bool FROMIN = false>
__device__ __forceinline__ void ph_rowpass(const KCtx& a, int layer, int which) {
    const int tid = TIDX(a), lane = tid & 63, wave = rfl(tid >> 6), gw = a.bx * NWAVES + wave, NGW = a.G * NWAVES;
    const float* X = (COMBINE || which == 1) ? WSP(float, WS_X1) : WSP(float, WS_X); float* XW = WSP(float, WS_X);
    const float* XC = a.p->in[I_CTX]; const float* XL = a.p->in[I_X] - (size_t)CTX * D;
#define ROWP(r) (FROMIN ? (((r) < CTX ? XC : XL) + (size_t)(r) * D) : (X + (size_t)(r) * D))
    bf16_t* H = WSP(bf16_t, WS_H); const float* modv = WSP(float, WS_SMALL + SM_MODV);
    const int* tok_pos = WSP(int, WS_TOK + (size_t)T * 16); const float* tok_w = WSP(float, WS_TOK + (size_t)T * 8);
    f32x4 vn[4];
    { const int r0 = gw < T ? gw : 0;
#pragma unroll
      for (int j = 0; j < 4; ++j) vn[j] = *(const f32x4*)(ROWP(r0) + 4 * lane + 256 * j); }
    int tp0 = 0, tp1 = 0, tw0 = 0, tw1 = 0; u32x2 yn0[4], yn1[4];
    if (COMBINE) {
        const int rr = gw + lane * NGW;
        if (rr < T) { tp0 = tok_pos[rr * 2]; tp1 = tok_pos[rr * 2 + 1]; tw0 = __builtin_bit_cast(int, tok_w[rr * 2]); tw1 = __builtin_bit_cast(int, tok_w[rr * 2 + 1]); }
        const bf16_t* y0 = WSP(bf16_t, WS_Y) + (size_t)SHI(tp0, 0, lane) * D; const bf16_t* y1 = WSP(bf16_t, WS_Y) + (size_t)SHI(tp1, 0, lane) * D;
#pragma unroll
        for (int j = 0; j < 4; ++j) { yn0[j] = *(const u32x2*)(y0 + 4 * lane + 256 * j); yn1[j] = *(const u32x2*)(y1 + 4 * lane + 256 * j); }
    }
    int it = 0;
    for (int row = gw; row < T; row += NGW, ++it) {
        const int s = row < CTX ? 1 : 0;
        f32x4 v[4];
#pragma unroll
        for (int j = 0; j < 4; ++j) v[j] = vn[j];
        { const int rn = row + NGW < T ? row + NGW : row;
#pragma unroll
          for (int j = 0; j < 4; ++j) vn[j] = *(const f32x4*)(ROWP(rn) + 4 * lane + 256 * j); }
        u32x2 yc0[4], yc1[4]; float w0 = 0.f, w1 = 0.f;
        if (COMBINE) {
#pragma unroll
            for (int j = 0; j < 4; ++j) { yc0[j] = yn0[j]; yc1[j] = yn1[j]; }
            w0 = __builtin_bit_cast(float, SHI(tw0, it, lane)); w1 = __builtin_bit_cast(float, SHI(tw1, it, lane));
            const bf16_t* y0 = WSP(bf16_t, WS_Y) + (size_t)SHI(tp0, it + 1, lane) * D; const bf16_t* y1 = WSP(bf16_t, WS_Y) + (size_t)SHI(tp1, it + 1, lane) * D;
#pragma unroll
            for (int j = 0; j < 4; ++j) { yn0[j] = *(const u32x2*)(y0 + 4 * lane + 256 * j); yn1[j] = *(const u32x2*)(y1 + 4 * lane + 256 * j); }
        }
        if (FINAL && row < CTX) continue;
        if (COMBINE) {
            const int lp = FINAL ? 3 : layer - 1; const float* g2 = modv + ((lp * 2 + s) * 6 + 5) * 1024;
#pragma unroll
            for (int j = 0; j < 4; ++j) { const int col = 4 * lane + 256 * j; const u32x2 r0 = yc0[j], r1 = yc1[j]; const f32x4 g = *(const f32x4*)(g2 + col);
                v[j][0] += g[0] * (w0 * bflo(r0.x) + w1 * bflo(r1.x)); v[j][1] += g[1] * (w0 * bfhi(r0.x) + w1 * bfhi(r1.x));
                v[j][2] += g[2] * (w0 * bflo(r0.y) + w1 * bflo(r1.y)); v[j][3] += g[3] * (w0 * bfhi(r0.y) + w1 * bfhi(r1.y));
                if (!FINAL) *(f32x4*)(XW + (size_t)row * D + col) = v[j]; }
        }
        float ss = 0.f;
#pragma unroll
        for (int j = 0; j < 4; ++j) ss += (v[j][0] * v[j][0] + v[j][1] * v[j][1]) + (v[j][2] * v[j][2] + v[j][3] * v[j][3]);
        ss = wave_sum(ss, lane); const float r = 1.0f / sqrtf(ss * (1.0f / D) + 1e-6f);
        if (FINAL) {
            float* o = a.p->out + (size_t)(row - CTX) * D;
#pragma unroll
            for (int j = 0; j < 4; ++j) { const int col = 4 * lane + 256 * j; const f32x4 g = *(const f32x4*)(a.p->in[I_FING] + col); *(f32x4*)(o + col) = v[j] * r * g; }
            continue;
        }
        const float* mv = modv + ((layer * 2 + s) * 6 + which * 3) * 1024;
        float lg[8];
#pragma unroll
        for (int e = 0; e < 8; ++e) lg[e] = 0.f;
#pragma unroll
        for (int j = 0; j < 4; ++j) { const int col = 4 * lane + 256 * j; const f32x4 sh = *(const f32x4*)(mv + col), sc = *(const f32x4*)(mv + 1024 + col);
            const f32x4 y = v[j] * r * (sc + 1.0f) + sh;
            if (ROUTER) { *(unsigned*)((unsigned char*)H + (size_t)row * D + col) = pk4_f8(y[0] * F8_SH, y[1] * F8_SH, y[2] * F8_SH, y[3] * F8_SH); }
            else { u32x2 w; w.x = pk2(y[0], y[1]); w.y = pk2(y[2], y[3]); *(u32x2*)(H + (size_t)row * D + col) = w; }
            if (ROUTER) { const float* wr = a.p->in[I_MOER] + (size_t)(layer >> 1) * D * NEXP + (size_t)col * NEXP;
#pragma unroll
                for (int q = 0; q < 4; ++q) { const f32x4 wa = *(const f32x4*)(wr + q * 8), wb = *(const f32x4*)(wr + q * 8 + 4);
                    lg[0] += y[q] * wa[0]; lg[1] += y[q] * wa[1]; lg[2] += y[q] * wa[2]; lg[3] += y[q] * wa[3]; lg[4] += y[q] * wb[0]; lg[5] += y[q] * wb[1]; lg[6] += y[q] * wb[2]; lg[7] += y[q] * wb[3]; } }
        }
        if (ROUTER) {
            { float r4[4], r2[2], r1; const bool u5 = (lane & 32) != 0, u4 = (lane & 16) != 0, u3 = (lane & 8) != 0;
#pragma unroll
              for (int q = 0; q < 4; ++q) { const float mine = u5 ? lg[4 + q] : lg[q], send = u5 ? lg[q] : lg[4 + q]; r4[q] = mine + SHX(send, 32, lane); }
#pragma unroll
              for (int q = 0; q < 2; ++q) { const float mine = u4 ? r4[2 + q] : r4[q], send = u4 ? r4[q] : r4[2 + q]; r2[q] = mine + SHX(send, 16, lane); }
              { const float mine = u3 ? r2[1] : r2[0], send = u3 ? r2[0] : r2[1]; r1 = mine + SHX(send, 8, lane); }
              r1 += SHX(r1, 4, lane); r1 += SHX(r1, 2, lane); r1 += SHX(r1, 1, lane);
#pragma unroll
              for (int e = 0; e < 8; ++e) lg[e] = SHC(r1, 32 * (e >> 2) + 16 * ((e >> 1) & 1) + 8 * (e & 1)); }
            int e0 = 0; float b0 = lg[0];
#pragma unroll
            for (int e = 1; e < 8; ++e) if (lg[e] > b0) { b0 = lg[e]; e0 = e; }
            int e1 = -1; float b1 = -3.0e38f;
#pragma unroll
            for (int e = 0; e < 8; ++e) if (e != e0 && lg[e] > b1) { b1 = lg[e]; e1 = e; }
            if (lane == 0) { const float w0 = 1.0f / (1.0f + expf(b1 - b0));
                int* te = WSP(int, WS_TOK); float* tw = WSP(float, WS_TOK + (size_t)T * 8);
                te[row * 2] = e0; te[row * 2 + 1] = e1; tw[row * 2] = w0; tw[row * 2 + 1] = 1.0f - w0;
                LAS unsigned* cl = (LAS unsigned*)(a.L + LDS_MOE);
                lds_add(cl + e0, 1u); lds_add(cl + e1, 1u); }
        }
    }
    if (ROUTER) {
        __syncthreads();
        if (tid < NEXP) { LAS unsigned* cl = (LAS unsigned*)(a.L + LDS_MOE); const unsigned c = cl[tid]; cl[tid] = 0u; if (c) atomicAdd(WSP(unsigned, WS_CTL) + CW_MOECNT + (layer >> 1) * 64 + tid, c); }
        __syncthreads();
    }
}

#undef ROWP
template <int MODE>
__device__ __forceinline__ void ctx_gemm(const KCtx& a, const bf16_t* A, const bf16_t* Bt, int K, int NC, bf16_t* O, int ldc, const float* Xin, float* Xout, const float* gate, LAS unsigned char* lds) {
    const int tid = TIDX(a), lane = tid & 63, wave = rfl(tid >> 6), fr = lane & 15, fq = lane >> 4, slot = wave >> 2, ks = wave & 3;
    const int nitems = 16 * (NC / 32), nb = K / 128;
    LAS f32x4* red = (LAS f32x4*)lds;
    __syncthreads();
    for (int base = a.bx * 2; base < nitems; base += a.G * 2) {
        const int it = base + slot; const bool valid = it < nitems; const int itc = valid ? it : 0;
        const int r0 = (itc & 15) * 16, c0 = (itc >> 4) * 32;
        const int wslot = 8 * (fr >> 2) + (fr & 3);
        const bf16_t* xp = A + (size_t)(r0 + fr) * K + 8 * fq;
        const bf16_t* wp = Bt + (size_t)(c0 + wslot) * K + 8 * fq;
        f32x4 acc[2];
        acc[0] = (f32x4){0.f, 0.f, 0.f, 0.f}; acc[1] = acc[0];
        bf16x8 xa[4], wa[4][2], xb[4], wb[4][2];
#define CTX_LOAD(xf, wf, kk) do { _Pragma("unroll") for (int s = 0; s < 4; ++s) { xf[s] = *(const bf16x8*)(xp + (kk) + 32 * s); \
            wf[s][0] = *(const bf16x8*)(wp + (kk) + 32 * s); wf[s][1] = *(const bf16x8*)(wp + (size_t)4 * K + (kk) + 32 * s); } } while (0)
#define CTX_MMA(xf, wf) do { _Pragma("unroll") for (int s = 0; s < 4; ++s) { acc[0] = mfma16(wf[s][0], xf[s], acc[0]); acc[1] = mfma16(wf[s][1], xf[s], acc[1]); } } while (0)
        if (ks < nb) CTX_LOAD(xa, wa, ks * 128);
        for (int b = ks; b < nb; b += 8) {
            if (b + 4 < nb) CTX_LOAD(xb, wb, (b + 4) * 128);
            CTX_MMA(xa, wa);
            if (b + 8 < nb) CTX_LOAD(xa, wa, (b + 8) * 128);
            if (b + 4 < nb) CTX_MMA(xb, wb);
        }
#undef CTX_LOAD
#undef CTX_MMA
        if (ks != 0) { red[((slot * 4 + ks) * 2 + 0) * 64 + lane] = acc[0]; red[((slot * 4 + ks) * 2 + 1) * 64 + lane] = acc[1]; }
        __syncthreads();
        if (ks == 0 && valid) {
#pragma unroll
            for (int k2 = 1; k2 < 4; ++k2) { acc[0] = acc[0] + red[((slot * 4 + k2) * 2 + 0) * 64 + lane]; acc[1] = acc[1] + red[((slot * 4 + k2) * 2 + 1) * 64 + lane]; }
            const int row = r0 + fr, col = c0 + 8 * fq;
            if (MODE == 0) { u32x4 w; w.x = pk2(acc[0][0], acc[0][1]); w.y = pk2(acc[0][2], acc[0][3]); w.z = pk2(acc[1][0], acc[1][1]); w.w = pk2(acc[1][2], acc[1][3]); *(u32x4*)(O + (size_t)row * ldc + col) = w; }
            else if (MODE == 3) {
                const float sc = col < 1024 ? QSCALE : 1.0f;
                u32x4 w; w.x = pk2(acc[0][0] * sc, acc[0][1] * sc); w.y = pk2(acc[0][2] * sc, acc[0][3] * sc); w.z = pk2(acc[1][0] * sc, acc[1][1] * sc); w.w = pk2(acc[1][2] * sc, acc[1][3] * sc);
                if (col < 1024) *(u32x4*)((bf16_t*)Xout + (size_t)row * D + col) = w;
                else if (col < 2048) { *(u32x4*)((bf16_t*)gate + (size_t)row * D + col - 1024) = w; float ssq = 0.f;
#pragma unroll
                    for (int e = 0; e < 4; ++e) ssq += bflo(w[e]) * bflo(w[e]) + bfhi(w[e]) * bfhi(w[e]);
#pragma unroll
                    for (int o2 = 1; o2 < 16; o2 <<= 1) ssq = fmaxf(ssq, SHX(ssq, o2, lane));
                    const int cc = col - 1024; if (fr == 0) atomicMax((unsigned*)Xin + ((cc >> 7) * 2 + ((cc >> 6) & 1)) * 8 + ((cc & 63) >> 3), __builtin_bit_cast(unsigned, ssq)); }
                else *(u32x4*)(O + (size_t)row * ldc + col) = w;
            }
            else { const size_t o = (size_t)row * D + col;
                *(f32x4*)(Xout + o) = *(const f32x4*)(Xin + o) + *(const f32x4*)(gate + col) * acc[0]; *(f32x4*)(Xout + o + 4) = *(const f32x4*)(Xin + o + 4) + *(const f32x4*)(gate + col + 4) * acc[1]; }
        }
        __syncthreads();
    }
}

__device__ __forceinline__ bf16x8 trfrag(const LAS unsigned char* base, int pitchB, int k0, int c0, int lane) {
    const int g = lane >> 4, q = (lane & 15) >> 2, p = lane & 3;
    const LAS unsigned char* a0 = base + (k0 + 8 * g + q) * pitchB + (c0 + 4 * p) * 2;
    const s16x4 lo = ds_tr16(a0), hi = ds_tr16(a0 + 4 * pitchB);
    return (bf16x8){lo[0], lo[1], lo[2], lo[3], hi[0], hi[1], hi[2], hi[3]};
}
__device__ __forceinline__ bf16x8 rowfrag(const LAS unsigned char* base, int pitchB, int r0, int k0, int lane) {
    return *(const LAS bf16x8*)(base + (r0 + (lane & 15)) * pitchB + (k0 + 8 * (lane >> 4)) * 2);
}

constexpr int HG_CUM = 0, HG_KT = 32768, HG_VV = 50176, HG_QS = 67584, HG_QT = 84992, HG_SS = 102400, HG_PT = 137216, HG_LBV = 139264, HP = 272  ;
constexpr int P_EVQ = 0, P_EVFF = 512, P_EVI = 1536, P_EVG = 2048, P_EVU = 2560, P_EVV = 3072;

__device__ __forceinline__ void hg_gates_from(const KCtx& a, int j, int h, int dir, const u32x4 (&raw)[2], LAS unsigned char* lds) {
    const int tid = TIDX(a);
    LAS float* lbv = (LAS float*)(lds + HG_LBV); LAS float* CUM = (LAS float*)(lds + HG_CUM);
    if (tid < 128) { const float* lb = a.p->in[I_HGLB] + (size_t)dir * 2 * 512 + h * 128 + tid; lbv[tid] = (j == 0) ? 0.f : 1.0f / (1.0f + expf(lb[0] - lb[512])); }
    __syncthreads();
#pragma unroll
    for (int i = 0; i < 2; ++i) { const int p = tid + NTHR * i, row = p >> 4, c8 = (p & 15) * 8;
        *(LAS u32x4*)(lds + HG_KT + row * HP + c8 * 2) = raw[i];
#pragma unroll
        for (int e = 0; e < 8; ++e) { const unsigned w = raw[i][e >> 1]; const float f = (e & 1) ? bfhi(w) : bflo(w); const float lb = lbv[c8 + e];
            float lf = __logf(lb + (1.0f - lb) * sigm_f(f)); lf = fmaxf(lf, -30.0f); CUM[row * 128 + c8 + e] = lf; } }
}
__device__ __forceinline__ void hg_load_gates(const KCtx& a, int j, int c, int h, int dir, LAS unsigned char* lds) {
    const int tid = TIDX(a); const bf16_t* proj = WSP(bf16_t, WS_PROJ); u32x4 raw[2];
#pragma unroll
    for (int i = 0; i < 2; ++i) { const int p = tid + NTHR * i, row = p >> 4, c8 = (p & 15) * 8; raw[i] = *(const u32x4*)(proj + (size_t)(c * HCH + row) * EVEN_IN + P_EVFF + dir * 512 + h * 128 + c8); }
    hg_gates_from(a, j, h, dir, raw, lds);
}
__device__ __forceinline__ float hg_cumsum(const KCtx& a, int dir, LAS unsigned char* lds) {
    const int tid = TIDX(a), ch = tid & 127, part = tid >> 7;
    LAS float* CUM = (LAS float*)(lds + HG_CUM); LAS float* PT = (LAS float*)(lds + HG_PT);
    float run = 0.f;
    for (int i = 0; i < 16; ++i) { const int r = part * 16 + i, t = dir ? 63 - r : r; run += CUM[t * 128 + ch]; CUM[t * 128 + ch] = run; }
    PT[part * 128 + ch] = run;
    __syncthreads();
    float off = 0.f, tot = 0.f;
#pragma unroll
    for (int p = 0; p < 4; ++p) { const float v = PT[p * 128 + ch]; if (p < part) off += v; tot += v; }
    for (int i = 0; i < 16; ++i) { const int r = part * 16 + i, t = dir ? 63 - r : r; CUM[t * 128 + ch] += off; }
    return tot;
}
__device__ __forceinline__ void hg_unit_a(const KCtx& a, int j, int unit, LAS unsigned char* lds) {
    const int tid = TIDX(a), lane = tid & 63, wave = rfl(tid >> 6);
    const int dir = unit & 1, h = (unit >> 1) & 3, c = unit >> 3;
    __syncthreads();
    hg_load_gates(a, j, c, h, dir, lds);
    { const bf16_t* proj = WSP(bf16_t, WS_PROJ);
#pragma unroll
      for (int i = 0; i < 2; ++i) { const int p = tid + NTHR * i, row = p >> 4, c8 = (p & 15) * 8;
          *(LAS u32x4*)(lds + HG_VV + row * HP + c8 * 2) = *(const u32x4*)(proj + (size_t)(c * HCH + row) * EVEN_IN + P_EVI + h * 128 + c8); } }
    __syncthreads();
    const float tot = hg_cumsum(a, dir, lds);
    { const int ch = tid & 127, part = tid >> 7; LAS float* CUM = (LAS float*)(lds + HG_CUM); const float lb = ((LAS float*)(lds + HG_LBV))[ch];
      for (int i = 0; i < 16; ++i) { const int r = part * 16 + i, t = dir ? 63 - r : r; LAS bf16_t* kp = (LAS bf16_t*)(lds + HG_KT + t * HP) + ch;
          const float f = bf2f(*kp), kd = (1.0f - lb) * sigm_f(-f); *kp = (bf16_t)f2bf(kd * __expf(tot - CUM[t * 128 + ch])); }
      if (part == 0) WSP(float, WS_HGD)[(size_t)unit * 128 + ch] = __expf(tot); }
    __syncthreads();
    f32x4 acc[8];
#pragma unroll
    for (int i = 0; i < 8; ++i) acc[i] = (f32x4){0.f, 0.f, 0.f, 0.f};
#pragma unroll
    for (int ks = 0; ks < 2; ++ks) { const bf16x8 af = trfrag(lds + HG_KT, HP, 32 * ks, 16 * wave, lane);
#pragma unroll
        for (int vt = 0; vt < 8; ++vt) { const bf16x8 bf = trfrag(lds + HG_VV, HP, 32 * ks, 16 * vt, lane); acc[vt] = mfma16(af, bf, acc[vt]); } }
    bf16_t* U = WSP(bf16_t, WS_HGU) + (size_t)unit * 16384;
#pragma unroll
    for (int vt = 0; vt < 8; ++vt)
#pragma unroll
        for (int r = 0; r < 4; ++r) U[(16 * wave + 4 * (lane >> 4) + r) * 128 + 16 * vt + (lane & 15)] = (bf16_t)f2bf(acc[vt][r]);
}
__device__ __forceinline__ int hg_seq(int dir, int i) { return dir == 0 ? i : (i < NCC ? NCC - 1 - i : NCH - 1 - (i - NCC)); }
__device__ __forceinline__ void ph_hg_scan(const KCtx& a) {
    const unsigned* U = WSP(unsigned, WS_HGU); unsigned* Sst = WSP(unsigned, WS_HGS); const float* Dd = WSP(float, WS_HGD);
    for (int e = a.bx * NTHR + TIDX(a); e < 8 * 8192; e += a.G * NTHR) {
        const int v2 = e & 63, k = (e >> 6) & 127, hd = e >> 13, h = hd >> 1, dir = hd & 1;
        float s0 = 0.f, s1 = 0.f;
        constexpr int SCB = (NCH % 26 == 0) ? 26 : ((NCH % 4 == 0) ? 4 : 1);
        for (int i = 0; i < NCH; i += SCB) {
            unsigned u[SCB]; float d[SCB];
#pragma unroll
            for (int q = 0; q < SCB; ++q) { const int unit = (hg_seq(dir, i + q) * 4 + h) * 2 + dir; u[q] = U[(size_t)unit * 8192 + k * 64 + v2]; d[q] = Dd[(size_t)unit * 128 + k]; }
#pragma unroll
            for (int q = 0; q < SCB; ++q) { const int unit = (hg_seq(dir, i + q) * 4 + h) * 2 + dir; Sst[(size_t)unit * 8192 + k * 64 + v2] = pk2(s0, s1); s0 = d[q] * s0 + bflo(u[q]); s1 = d[q] * s1 + bfhi(u[q]); }
        }
    }
}
__device__ __forceinline__ void hg_unit_c(const KCtx& a, int j, int c, int h, LAS unsigned char* lds) {
    const int tid = TIDX(a), lane = tid & 63, wave = rfl(tid >> 6);
    const bf16_t* proj = WSP(bf16_t, WS_PROJ);
    u32x4 rq[2], rv[2], fg0[2], fg1[2], gr[2]; u32x2 s0[8], s1[8];
#pragma unroll
    for (int i = 0; i < 2; ++i) { const int p = tid + NTHR * i, row = p >> 4, c8 = (p & 15) * 8; const bf16_t* src = proj + (size_t)(c * HCH + row) * EVEN_IN + h * 128 + c8;
        rq[i] = *(const u32x4*)(src + P_EVQ); rv[i] = *(const u32x4*)(src + P_EVI); fg0[i] = *(const u32x4*)(src + P_EVFF); fg1[i] = *(const u32x4*)(src + P_EVFF + 512); }
    { const bf16_t* Sg = WSP(bf16_t, WS_HGS) + (size_t)((c * 4 + h) * 2) * 16384;
#pragma unroll
      for (int i = 0; i < 8; ++i) { const int p = tid + NTHR * i, k = p >> 5, v4 = (p & 31) * 4; s0[i] = *(const u32x2*)(Sg + k * 128 + v4); s1[i] = *(const u32x2*)(Sg + 16384 + k * 128 + v4); } }
    { const int t = tid >> 3, v0 = (tid & 7) * 16; const bf16_t* gsrc = proj + (size_t)(c * HCH + t) * EVEN_IN + P_EVG + h * 128 + v0; gr[0] = *(const u32x4*)gsrc; gr[1] = *(const u32x4*)(gsrc + 8); }
    __syncthreads();
#pragma unroll
    for (int i = 0; i < 2; ++i) { const int p = tid + NTHR * i, row = p >> 4, c8 = (p & 15) * 8;
        u32x4 sq;
#pragma unroll
        for (int e = 0; e < 4; ++e) sq[e] = pk2(silu_f(bflo(rq[i][e])), silu_f(bfhi(rq[i][e])));
        *(LAS u32x4*)(lds + HG_QS + row * HP + c8 * 2) = sq;
        *(LAS u32x4*)(lds + HG_VV + row * HP + c8 * 2) = rv[i]; }
    const int rt = wave >> 1;
    f32x4 acc[4];
#pragma unroll
    for (int i = 0; i < 4; ++i) acc[i] = (f32x4){0.f, 0.f, 0.f, 0.f};
#pragma unroll
    for (int dir = 0; dir < 2; ++dir) {
        __syncthreads();
        hg_gates_from(a, j, h, dir, dir ? fg1 : fg0, lds);
        __syncthreads();
        (void)hg_cumsum(a, dir, lds);
        __syncthreads();
        const int tp = dir ? 31 : 32;
        LAS float* CUM = (LAS float*)(lds + HG_CUM);
        { const int ch = tid & 127, part = tid >> 7; const float lb = ((LAS float*)(lds + HG_LBV))[ch]; const float cp = CUM[tp * 128 + ch];
          for (int i = 0; i < 16; ++i) { const int r = part * 16 + i, t = dir ? 63 - r : r; const float cum = CUM[t * 128 + ch];
              LAS bf16_t* kp = (LAS bf16_t*)(lds + HG_KT + t * HP) + ch; const float f = bf2f(*kp), kd = (1.0f - lb) * sigm_f(-f);
              *kp = (bf16_t)f2bf(kd * __expf(fminf(cp - cum, 80.f)));
              const float qs = bf2f(*((LAS bf16_t*)(lds + HG_QS + t * HP) + ch));
              *((LAS bf16_t*)(lds + HG_QT + t * HP) + ch) = (bf16_t)f2bf(qs * __expf(fminf(cum - cp, 80.f))); } }
#pragma unroll
        for (int i = 0; i < 8; ++i) { const int p = tid + NTHR * i, k = p >> 5, v4 = (p & 31) * 4; const u32x2 s = dir ? s1[i] : s0[i]; const float e = __expf(CUM[tp * 128 + k]);
            u32x2 w; w.x = pk2(bflo(s.x) * e, bfhi(s.x) * e); w.y = pk2(bflo(s.y) * e, bfhi(s.y) * e); *(LAS u32x2*)(lds + HG_SS + k * HP + v4 * 2) = w; }
        __syncthreads();
#pragma unroll
        for (int ii = 0; ii < 2; ++ii) { const int st = 2 * (wave & 1) + ii; f32x4 pa = (f32x4){0.f, 0.f, 0.f, 0.f};
#pragma unroll
            for (int ks = 0; ks < 4; ++ks) pa = mfma16(rowfrag(lds + HG_QT, HP, 16 * rt, 32 * ks, lane), rowfrag(lds + HG_KT, HP, 16 * st, 32 * ks, lane), pa);
            const int s = 16 * st + (lane & 15);
#pragma unroll
            for (int r = 0; r < 4; ++r) { const int t = 16 * rt + 4 * (lane >> 4) + r; const bool keep = dir ? (s >= t) : (s <= t);
                *((LAS bf16_t*)(lds + HG_CUM + t * 144) + s) = (bf16_t)f2bf(keep ? pa[r] : 0.f); } }
        __syncthreads();
#pragma unroll
        for (int i = 0; i < 4; ++i) { const int ct = 4 * (wave & 1) + i;
#pragma unroll
            for (int ks = 0; ks < 2; ++ks) acc[i] = mfma16(rowfrag(lds + HG_CUM, 144, 16 * rt, 32 * ks, lane), trfrag(lds + HG_VV, HP, 32 * ks, 16 * ct, lane), acc[i]);
#pragma unroll
            for (int ks = 0; ks < 4; ++ks) acc[i] = mfma16(rowfrag(lds + HG_QT, HP, 16 * rt, 32 * ks, lane), trfrag(lds + HG_SS, HP, 32 * ks, 16 * ct, lane), acc[i]); }
    }
    __syncthreads();
    LAS float* OB = (LAS float*)(lds + HG_CUM);
#pragma unroll
    for (int i = 0; i < 4; ++i)
#pragma unroll
        for (int r = 0; r < 4; ++r) OB[(16 * rt + 4 * (lane >> 4) + r) * 128 + 16 * (4 * (wave & 1) + i) + (lane & 15)] = acc[i][r];
    __syncthreads();
    { const int t = tid >> 3, v0 = (tid & 7) * 16; float o[16]; float ss = 0.f;
#pragma unroll
      for (int q = 0; q < 16; ++q) { o[q] = OB[t * 128 + v0 + q]; ss += o[q] * o[q]; }
      ss += SHX(ss, 1, lane); ss += SHX(ss, 2, lane); ss += SHX(ss, 4, lane);
      const float r = 1.0f / sqrtf(ss * (1.0f / 128.0f) + 1e-6f);
      const float* gain = a.p->in[I_HGNG] + j * 128 + v0;
      bf16_t* dst = WSP(bf16_t, WS_MIX) + (size_t)(c * HCH + t) * D + h * 128 + v0;
#pragma unroll
      for (int hh = 0; hh < 2; ++hh) { const u32x4 grr = gr[hh]; u32x4 w;
#pragma unroll
          for (int e = 0; e < 4; ++e) { const int q = hh * 8 + 2 * e; w[e] = pk2(o[q] * r * gain[q] * silu_f(bflo(grr[e])), o[q + 1] * r * gain[q + 1] * silu_f(bfhi(grr[e]))); }
          *(u32x4*)(dst + hh * 8) = w; } }
}
constexpr int SG_W = 0, SG_VN = 34816, SG_ST = 69632;
__device__ __forceinline__ void sg_unit(const KCtx& a, int j, int cs, LAS unsigned char* lds) {
    const int tid = TIDX(a), lane = tid & 63, wave = rfl(tid >> 6);
    const bf16_t* proj = WSP(bf16_t, WS_PROJ); const int row0 = cs * SGC;
    __syncthreads();
    { const int t = tid >> 2, qd = tid & 3; float s = 0.f, s2 = 0.f;
      for (int i = 0; i < 16; ++i) { const u32x4 raw = *(const u32x4*)(proj + (size_t)(row0 + t) * EVEN_IN + P_EVV + qd * 128 + i * 8);
#pragma unroll
          for (int e = 0; e < 4; ++e) { const float x0 = gelu_f(bflo(raw[e])), x1 = gelu_f(bfhi(raw[e])); s += x0 + x1; s2 += x0 * x0 + x1 * x1; } }
      s += SHX(s, 1, lane); s += SHX(s, 2, lane); s2 += SHX(s2, 1, lane); s2 += SHX(s2, 2, lane);
      const float mean = s * (1.0f / 512.0f), var = fmaxf(s2 * (1.0f / 512.0f) - mean * mean, 0.f);
      if (qd == 0) { ((LAS float*)(lds + SG_ST))[t * 2] = mean; ((LAS float*)(lds + SG_ST))[t * 2 + 1] = 1.0f / sqrtf(var + 1e-5f); } }
    for (int g = 0; g < 4; ++g) {
        __syncthreads();
        const bf16_t* sgw = WSP(bf16_t, WS_SGW) + (size_t)(j * 4 + g) * 16384;
#pragma unroll
        for (int i = 0; i < 4; ++i) { const int p = tid + NTHR * i, r = p >> 4, c8 = (p & 15) * 8;
            *(LAS u32x4*)(lds + SG_W + r * HP + c8 * 2) = *(const u32x4*)(sgw + r * 128 + c8);
            const u32x4 raw = *(const u32x4*)(proj + (size_t)(row0 + r) * EVEN_IN + P_EVV + g * 128 + c8);
            const float mean = ((LAS float*)(lds + SG_ST))[r * 2], rstd = ((LAS float*)(lds + SG_ST))[r * 2 + 1];
            const float* lg = a.p->in[I_SGLNG] + j * 512 + g * 128 + c8; const float* lb = a.p->in[I_SGLNB] + j * 512 + g * 128 + c8;
            u32x4 w;
#pragma unroll
            for (int e = 0; e < 4; ++e) w[e] = pk2((gelu_f(bflo(raw[e])) - mean) * rstd * lg[2 * e] + lb[2 * e], (gelu_f(bfhi(raw[e])) - mean) * rstd * lg[2 * e + 1] + lb[2 * e + 1]);
            *(LAS u32x4*)(lds + SG_VN + r * HP + c8 * 2) = w; }
        __syncthreads();
        f32x4 acc[8];
#pragma unroll
        for (int i = 0; i < 8; ++i) acc[i] = (f32x4){0.f, 0.f, 0.f, 0.f};
#pragma unroll
        for (int ks = 0; ks < 4; ++ks) { const bf16x8 af = rowfrag(lds + SG_W, HP, 16 * wave, 32 * ks, lane);
#pragma unroll
            for (int ct = 0; ct < 8; ++ct) acc[ct] = mfma16(af, trfrag(lds + SG_VN, HP, 32 * ks, 16 * ct, lane), acc[ct]); }
        const float* sb = a.p->in[I_SGB] + (size_t)(j * 4 + g) * 128;
#pragma unroll
        for (int r = 0; r < 4; ++r) { const int t = 16 * wave + 4 * (lane >> 4) + r; const float bias = sb[t];
            const bf16_t* up = proj + (size_t)(row0 + t) * EVEN_IN + P_EVU + g * 128 + (lane & 15); bf16_t* dst = WSP(bf16_t, WS_MIX) + (size_t)(row0 + t) * D + 512 + g * 128 + (lane & 15);
#pragma unroll
            for (int ct = 0; ct < 8; ++ct) dst[16 * ct] = (bf16_t)f2bf((acc[ct][r] + bias) * gelu_f(bf2f(up[16 * ct]))); }
    }
}

constexpr int AT_SLOT = 32768, AT_V = 16384, AT_L = 3 * AT_SLOT, AT_Q = AT_L + 4096;
__device__ __forceinline__ int crow(int r, int hi) { return (r & 3) + 8 * (r >> 2) + 4 * hi; }
#ifdef CPU_SIM
#define PIN_P(w, l) do {} while (0)
#else
#define PIN_P(w, l) asm volatile("" : "+v"(w[0]), "+v"(w[1]), "+v"(l))
#endif
#define AT_KF(kb, d0) (*(const LAS bf16x8*)((kb) + (2 * (d0)) * 1024))
#define AT_VF(dst, vbh, db, ss) do { const LAS unsigned char* vp_ = (vbh) + (db) * 4096 + (ss) * 1024; const s16x4 lo_ = ds_tr16(vp_), hh_ = ds_tr16(vp_ + 512); \
        dst = (bf16x8){lo_[0], lo_[1], lo_[2], lo_[3], hh_[0], hh_[1], hh_[2], hh_[3]}; } while (0)
#define AT_STEP(pN, kbN, MN, DOS, pM, wN, lacc, DOX, OACC, wO, vbO, KNEXT, kbNext, vbNext) do { \
    _Pragma("unroll") for (int q_ = 0; q_ < 4; ++q_) { \
        bf16x8 kfc_ = kf, kfn_ = kf, qq_ = vfa, vfan_, vfbn_; \
        if (q_ < 3) { if (DOS) kfn_ = AT_KF(kbN, q_ + 1); } else if (KNEXT) kfn_ = AT_KF(kbNext, 0); \
        if (DOS) { qq_ = (MN == 0 || AV == 2) ? qf[q_] : *(const LAS bf16x8*)(qb1 + q_ * 1024); } \
        if (AV == 2) { vfan_ = vfa; vfbn_ = vfb; } else \
        if (q_ < 3) { AT_VF(vfan_, vbO, q_ + 1, 0); AT_VF(vfbn_, vbO, (q_ + 3) & 3, 1); } else { AT_VF(vfan_, vbNext, 0, 0); AT_VF(vfbn_, vbNext, 2, 1); } \
        SCHED_FENCE();     \
        if (AV == 6) { bf16x8 d0_, d1_; if (q_ < 3) { AT_VF(d0_, vbO, q_ + 1, 1); AT_VF(d1_, vbO, (q_ + 3) & 3, 0); } else { AT_VF(d0_, vbNext, 0, 1); AT_VF(d1_, vbNext, 2, 0); } asm volatile("" :: "v"(d0_), "v"(d1_)); } \
        if (AV == 7) { bf16x8 d0_ = AT_KF(kbN, q_), d1_ = AT_KF(kbN, (q_ + 1) & 3); asm volatile("" :: "v"(d0_), "v"(d1_)); } \
        if (AV != 3) { OACC[q_] = mfma32(__builtin_bit_cast(bf16x8, wO[0]), vfa, OACC[q_]); OACC[(q_ + 2) & 3] = mfma32(__builtin_bit_cast(bf16x8, wO[1]), vfb, OACC[(q_ + 2) & 3]); } \
        if (DOS && AV != 4) { if (q_ == 0) pN = mfma32(kfc_, qq_, negmv); else pN = mfma32(kfc_, qq_, pN); } \
        if (DOX) { _Pragma("unroll") for (int r_ = 4 * q_; r_ < 4 * q_ + 4; ++r_) { if (AV != 1) pM[r_] = fexp2(pM[r_]); lacc += pM[r_]; } \
            wN[q_ >> 1][(q_ & 1) * 2] = pk2(pM[4 * q_], pM[4 * q_ + 1]); wN[q_ >> 1][(q_ & 1) * 2 + 1] = pk2(pM[4 * q_ + 2], pM[4 * q_ + 3]); } \
        vfa = vfan_; vfb = vfbn_; kf = kfn_; \
        SCHED_FENCE(); } \
    if (DOX) { PIN_P(wN, lacc); } } while (0)
template <int AV>
__device__ __forceinline__ void attn_unit(const KCtx& a, int j, int h, int q0, int nkeys, LAS unsigned char* lds) {
    int tid = FRESH_TID(a); OPAQUE(tid);
    const int lane = tid & 63, wid = a.wv, r32 = lane & 31, hi = lane >> 5;
    const bf16_t* QR = WSP(bf16_t, WS_QR); const bf16_t* KR = WSP(bf16_t, WS_KR) + h * 128; const bf16_t* VP = WSP(bf16_t, WS_PROJ) + 2048 + h * 128;
    const int qrow = q0 + wid * 32 + r32, NT = nkeys / 64;
    __syncthreads();
    int koff = (lane * D + wid * 8) * 2, voff = ((16 * (wid & 3) + (lane >> 2)) * DQKV + (wid >> 2) * 32 + (lane & 3) * 8) * 2;
    OPAQUE(koff); OPAQUE(voff);
#define DMA_TILE(t, slot) do { const unsigned char* ks_ = (const unsigned char*)KR + (size_t)(t) * 64 * D * 2; const unsigned char* vs_ = (const unsigned char*)VP + (size_t)(t) * 64 * DQKV * 2; \
        LAS unsigned char* sl_ = lds + (slot) * AT_SLOT + wid * 1024; \
        glds16s(ks_, koff, sl_); glds16s(ks_ + 128, koff, sl_ + 8192); glds16s(vs_, voff, sl_ + AT_V); glds16s(vs_ + 128, voff, sl_ + AT_V + 8192); } while (0)
    DMA_TILE(0, 0);
    if (NT > 1) DMA_TILE(1, 1);
    bf16x8 qf[4];
    int qbo = AT_Q + wid * 4096 + hi * 512 + r32 * 16; OPAQUE(qbo);
    const LAS unsigned char* qb1 = lds + qbo;
#pragma unroll
    for (int d0 = 0; d0 < 4; ++d0) { qf[d0] = *(const bf16x8*)(QR + (size_t)qrow * D + h * 128 + d0 * 16 + hi * 8);
        *(LAS bf16x8*)(lds + qbo + d0 * 1024) = *(const bf16x8*)(QR + (size_t)qrow * D + h * 128 + 64 + d0 * 16 + hi * 8); }
    float negm;
    { float qs0 = 0.f, qs1 = 0.f;
#pragma unroll
      for (int d0 = 0; d0 < 4; ++d0) { const bf16x8 q1f = *(const LAS bf16x8*)(qb1 + d0 * 1024);
#pragma unroll
          for (int e = 0; e < 8; ++e) { const float x0 = bf2f((bf16_t)qf[d0][e]), x1 = bf2f((bf16_t)q1f[e]); qs0 += x0 * x0; qs1 += x1 * x1; } }
      qs0 += SHX(qs0, 32, lane); qs1 += SHX(qs1, 32, lane);
      const unsigned* kbw = WSP(unsigned, WS_CTL) + CW_KB + j * 128 + h * 16; float k0 = 0.f, k1 = 0.f;
#pragma unroll
      for (int e = 0; e < 8; ++e) { k0 += __builtin_bit_cast(float, kbw[e]); k1 += __builtin_bit_cast(float, kbw[8 + e]); }
      negm = -(sqrtf(fmaxf(qs0, qs1)) * sqrtf(fmaxf(k0, k1)) * 1.0005f + 1e-3f); }
    f32x16 O0[4], O1[4];
#pragma unroll
    for (int i = 0; i < 4; ++i)
#pragma unroll
        for (int r = 0; r < 16; ++r) { O0[i][r] = 0.f; O1[i][r] = 0.f; }
    float l0 = 0.f, l1 = 0.f;
    f32x16 negmv;
#pragma unroll
    for (int r = 0; r < 16; ++r) negmv[r] = negm;
    int vb = AT_V + ((lane >> 4) & 1) * 32 + (lane & 3) * 8 + (4 * hi + ((lane & 15) >> 2)) * 64; OPAQUE(vb);
    int kbo = hi * 1024 + r32 * 16; OPAQUE(kbo);
    f32x16 pA, pB; u32x4 wA[2], wB[2]; bf16x8 vfa, vfb, kf;
    WAIT_DMA_BAR();
    int sc = 0, sn = AT_SLOT, sp = 2 * AT_SLOT;
    {
#pragma unroll
        for (int r = 0; r < 16; ++r) { pA[r] = negm; pB[r] = negm; }
#pragma unroll
        for (int d0 = 0; d0 < 4; ++d0) { pB = mfma32(AT_KF(lds + kbo, d0), qf[d0], pB); pA = mfma32(AT_KF(lds + kbo + 8192, d0), *(const LAS bf16x8*)(qb1 + d0 * 1024), pA); }
#pragma unroll
        for (int r = 0; r < 16; ++r) { pB[r] = fexp2(pB[r]); l0 += pB[r]; }
#pragma unroll
        for (int e = 0; e < 4; ++e) { wA[0][e] = pk2(pB[2 * e], pB[2 * e + 1]); wA[1][e] = pk2(pB[8 + 2 * e], pB[8 + 2 * e + 1]); }
        AT_VF(vfa, lds + vb, 0, 0); AT_VF(vfb, lds + vb, 2, 1); kf = AT_KF(lds + kbo + 512, 0);
    }
    for (int kt = 0; kt < NT; ++kt) {
        const bool more = kt + 1 < NT;
        SCHED_FENCE();
        const LAS unsigned char* kc = lds + kbo + sc; const LAS unsigned char* kn = lds + kbo + sn; const LAS unsigned char* vc = lds + vb + sc; const LAS unsigned char* vn = lds + vb + sn;
        AT_STEP(pB, kc + 512, 0, true, pA, wB, l1, true, O0, wA, vc, true, kc + 512 + 8192, vc);
        AT_STEP(pA, kc + 512 + 8192, 1, true, pB, wA, l0, true, O1, wB, vc, false, kc, vc + 2048);
        if (AV != 5) { WAIT_DMA_BAR_KEEP();
        if (kt + 2 < NT) DMA_TILE(kt + 2, (kt + 2) % 3); }
        if (more) { kf = AT_KF(kn, 0);
            AT_STEP(pB, kn, 0, true, pA, wB, l1, true, O0, wA, vc + 2048, true, kn + 8192, vc + 2048);
            AT_STEP(pA, kn + 8192, 1, true, pB, wA, l0, true, O1, wB, vc + 2048, true, kn + 512, vn);
        } else {
            AT_STEP(pB, kn, 0, false, pA, wB, l1, true, O0, wA, vc + 2048, false, kn, vc + 2048);
            AT_STEP(pA, kn, 1, false, pB, wA, l0, false, O1, wB, vc + 2048, false, kn, vc + 2048);
        }
        { const int t_ = sc; sc = sn; sn = sp; sp = t_; }
    }
#undef DMA_TILE
    SCHED_FENCE();
    int tid3 = FRESH_TID(a); OPAQUE(tid3);
    const int lane3 = tid3 & 63, wid3 = a.wv, r3 = lane3 & 31, hi3 = lane3 >> 5;
    LAS float* lb = (LAS float*)(lds + AT_L) + wid3 * 128;
    lb[hi3 * 32 + r3] = l0; lb[64 + hi3 * 32 + r3] = l1;
    WAVE_SYNC();
    const float lam = WSP(float, WS_SMALL + SM_LAMF)[j];
    const float lam_init = 0.8f - 0.6f * expf(-0.3f * (float)(2 * j + 1));
    const float* subg = a.p->in[I_DASUBG] + j * 128;
    bf16_t* dst = WSP(bf16_t, WS_MIX) + (size_t)(q0 + wid3 * 32) * D + h * 128 + r3;
#pragma unroll
    for (int r = 0; r < 16; ++r) { SCHED_FENCE(); const int q = crow(r, hi3); const float li0 = 1.0f / (lb[q] + lb[32 + q]), li1 = lam / (lb[64 + q] + lb[96 + q]);
        float o[4]; float ss = 0.f;
#pragma unroll
        for (int db = 0; db < 4; ++db) { o[db] = O0[db][r] * li0 - O1[db][r] * li1; ss += o[db] * o[db]; }
#pragma unroll
        for (int ofs = 1; ofs < 32; ofs <<= 1) ss += SHX(ss, ofs, lane3);
        const float rn = (1.0f - lam_init) / sqrtf(ss * (1.0f / 128.0f) + 1e-5f);
#pragma unroll
        for (int db = 0; db < 4; ++db) dst[(size_t)q * D + db * 32] = (bf16_t)f2bf(o[db] * rn * subg[db * 32 + r3]); }
}
template <int AV = 0>
__device__ __forceinline__ void ph_attn(const KCtx& a, int j, LAS unsigned char* lds) {
    constexpr int NQT = SEQ / 256;
    for (int u = a.bx; u < NQT * 8 + 8; u += a.G) {
        const bool lat = u < NQT * 8;
        attn_unit<AV>(a, j, lat ? (u & 7) : (u - NQT * 8), lat ? CTX + (u >> 3) * 256 : 0, lat ? T : CTX, lds);
    }
}

__device__ __forceinline__ void ph_moe_assign(const KCtx& a, int j) {
    const int tid = TIDX(a), lane = tid & 63, wave = rfl(tid >> 6), gw = a.bx * NWAVES + wave, NGW = a.G * NWAVES;
    unsigned* cnt = WSP(unsigned, WS_CTL) + CW_MOECNT + j * 64; unsigned* cur = WSP(unsigned, WS_CTL) + CW_MOECUR + j * 64;
    int start[NEXP + 1]; start[0] = 0;
#pragma unroll
    for (int e = 0; e < NEXP; ++e) start[e + 1] = start[e] + (int)((cnt[e] + 255u) / 256u) * 256;
    int* tab = WSP(int, WS_SMALL + SM_MOETAB);
    if (a.bx == 0 && tid == 0) { const int ntr = start[NEXP] / 256; tab[0] = ntr;
        for (int rt = 0; rt < ntr; ++rt) { int e = 0;
#pragma unroll
            for (int q = 1; q < NEXP; ++q) if (rt * 256 >= start[q]) e = q;
            tab[16 + rt] = e; } }
    const int* te = WSP(int, WS_TOK); int* tp = WSP(int, WS_TOK + (size_t)T * 16);
    const bf16_t* H = WSP(bf16_t, WS_H); bf16_t* AG = WSP(bf16_t, WS_AG);
    int mypos = 0;
    { const int idx = gw + lane * NGW; LAS unsigned* cl = (LAS unsigned*)(a.L + LDS_MOE);
      int e = 0, st = 0; unsigned lr = 0u;
      if (idx < 2 * T) { e = te[idx];
#pragma unroll
          for (int q = 0; q < NEXP; ++q) if (q == e) st = start[q];
          lr = lds_add(cl + e, 1u); }
      __syncthreads();
      if (tid < NEXP) { const unsigned c = cl[tid]; cl[NEXP + tid] = c ? atomicAdd(cur + tid, c) : 0u; }
      __syncthreads();
      if (idx < 2 * T) { mypos = st + (int)(cl[NEXP + e] + lr); tp[idx] = mypos; }
      __syncthreads();
      if (tid < 2 * NEXP) cl[tid] = 0u; }
    int it = 0;
    for (int idx = gw; idx < 2 * T; idx += NGW, ++it) {
        const int pos = SHI(mypos, it, lane);
        const u32x4* src = (const u32x4*)((const unsigned char*)H + (size_t)(idx >> 1) * D); u32x4* dst = (u32x4*)((unsigned char*)AG + (size_t)pos * D);
        dst[lane] = src[lane];
    }
}

constexpr int N_PHASES = 38;
__global__ void __launch_bounds__(NTHR, 2) fwd_kernel(KArgs ka) {
#ifdef CPU_SIM
    unsigned char* lds = sim_lds();
#else
    extern __shared__ __attribute__((aligned(16))) unsigned char lds_raw[];
    LAS unsigned char* lds = (LAS unsigned char*)lds_raw;
#endif
    KCtx a;
#ifdef CPU_SIM
    a.p = &ka; a.wv = (int)threadIdx.x >> 6; a.tid = (int)threadIdx.x; a.bx = (int)blockIdx.x; a.G = (int)gridDim.x; a.L = lds;
#define NEWCTX() do {} while (0)
#else
    const int wv0 = rfl((int)threadIdx.x >> 6); a.wv = wv0;
#define NEWCTX() do { unsigned long long kp_ = (unsigned long long)__builtin_amdgcn_kernarg_segment_ptr(); asm volatile("" : "+s"(kp_)); a.p = (KArgP)kp_; \
        int b_ = (int)blockIdx.x, g_ = (int)gridDim.x, w_ = wv0, l_ = 0; asm volatile("" : "+s"(b_), "+s"(g_), "+s"(w_), "+s"(l_)); a.bx = b_; a.G = g_; a.wv = w_; a.L = lds + l_; \
        unsigned z2_ = 0u; asm volatile("" : "+s"(z2_)); int t_ = w_ * 64 + (int)__builtin_amdgcn_mbcnt_hi(~0u, __builtin_amdgcn_mbcnt_lo(~0u, z2_)); asm volatile("" : "+v"(t_)); a.tid = t_; } while (0)
    NEWCTX();
#endif
    const int tid = TIDX(a);
    for (int u = tid; u < (LDS_BYTES - LDS_MISC) / 4; u += NTHR) ((LAS unsigned*)(lds + LDS_MISC))[u] = 0u;
    __syncthreads();
#if !defined(CPU_SIM) && N_LAUNCH_MODE == 0
    XcdBarrier bar = xcd_barrier_post(WSP(unsigned, WS_CTL) + CW_BAR, (volatile LAS unsigned*)(lds + LDS_MISC + 32), tid);
#define SEAM() do { XcdBarrier b_ = bar; unsigned long long bp_ = (unsigned long long)b_.bar; unsigned bxx_ = b_.x; asm volatile("" : "+s"(bp_), "+s"(bxx_)); b_.bar = (unsigned*)bp_; b_.x = bxx_; xcd_barrier(b_, FRESH_TID(a)); } while (0)
#else
#define SEAM() do {} while (0)
#endif
    const int lo = a.p->ph_lo, hi = a.p->ph_hi;
#ifdef ONLY_SITE
#define SITE(k) (ONLY_SITE == (k))
#else
#define SITE(k) 1
#endif
#ifdef PROBE_SITE
#define REPS(k) ((PROBE_SITE == (k)) ? PROBE_REPS : 1)
#else
#define REPS(k) 1
#endif
#define IN(p) (lo <= (p) && (p) < hi)
#define ENDPH(p) do { if (IN((p) + 1)) SEAM(); } while (0)
#define ENDPH2(p) do { if (IN((p) + 2)) SEAM(); } while (0)
#define modv WSP(float, WS_SMALL + SM_MODV)
#define moetab WSP(int, WS_SMALL + SM_MOETAB)

    if (SITE(0) && IN(0)) { NEWCTX(); for (int rep_ = 0; rep_ < REPS(0); ++rep_) { ph_prologue(a, a.L); } ENDPH(0); }
    for (int pr = 0; pr < 2; ++pr) {
        const int j = pr, Le = 2 * pr, Lo = 2 * pr + 1, be = 1 + 9 * Le, bo = 1 + 9 * Lo;
        if (SITE(1) && IN(be + 0)) { NEWCTX(); for (int rep_ = 0; rep_ < REPS(1); ++rep_) { if (pr == 0) ph_rowpass<false, false, false, true>(a, Le, 0); else ph_rowpass<true, false, false>(a, Le, 0); } ENDPH(be + 0); }
        if (SITE(2) && IN(be + 1)) { NEWCTX(); for (int rep_ = 0; rep_ < REPS(2); ++rep_) {
            pg8::Gemm g{WSP(bf16_t, WS_H), WSP(bf16_t, WS_WIN + j * SZ_WIN), T, EVEN_IN, D}; pg8::StaticOrder S; S.init(T, EVEN_IN, a.G, a.bx);
            pg8::EpiStoreBf16 E{WSP(bf16_t, WS_PROJ), EVEN_IN, EVEN_IN / 256};
            pg8::gemm_phase<pg8::EpiStoreBf16, pg8::StaticOrder, true, true>(a.L, g, S, E, TIDX(a)); } ENDPH(be + 1); }
        if (SITE(3) && IN(be + 2)) { NEWCTX(); for (int rep_ = 0; rep_ < REPS(3); ++rep_) { for (int u = a.bx; u < NSG + NCH * 8; u += a.G) { if (u < NSG) sg_unit(a, j, u, a.L); else hg_unit_a(a, j, u - NSG, a.L); } } ENDPH(be + 2); }
        if (SITE(4) && IN(be + 3)) { NEWCTX(); for (int rep_ = 0; rep_ < REPS(4); ++rep_) { ph_hg_scan(a); } ENDPH(be + 3); }
        if (SITE(5) && IN(be + 4)) { NEWCTX(); for (int rep_ = 0; rep_ < REPS(5); ++rep_) { for (int u = a.bx; u < NCH * 4; u += a.G) hg_unit_c(a, j, u >> 2, u & 3, a.L); } ENDPH(be + 4); }
        if (SITE(6) && IN(be + 5)) { NEWCTX(); for (int rep_ = 0; rep_ < REPS(6); ++rep_) {
            pg8::Gemm g{WSP(bf16_t, WS_MIX) + (size_t)CTX * D, WSP(bf16_t, WS_WEO + j * SZ_WSQ), SEQ, D, D}; pg8::StaticOrder S; S.init(SEQ, D, a.G, a.bx);
            pg8::EpiResid E{pr == 0 ? a.p->in[I_X] : WSP(float, WS_X) + (size_t)CTX * D, WSP(float, WS_X1) + (size_t)CTX * D, modv + ((Le * 2 + 0) * 6 + 2) * 1024, modv + ((Le * 2 + 0) * 6 + 2) * 1024};
            pg8::gemm_phase<pg8::EpiResid, pg8::StaticOrder, true, true>(a.L, g, S, E, TIDX(a));
            ctx_gemm<1>(a, WSP(bf16_t, WS_MIX), WSP(bf16_t, WS_WEO + j * SZ_WSQ), D, D, nullptr, 0, pr == 0 ? a.p->in[I_CTX] : WSP(float, WS_X), WSP(float, WS_X1), modv + ((Le * 2 + 1) * 6 + 2) * 1024, a.L); } ENDPH(be + 5); }
        if (SITE(7) && IN(be + 6)) { NEWCTX(); for (int rep_ = 0; rep_ < REPS(7); ++rep_) { ph_rowpass<false, false, false>(a, Le, 1); } ENDPH(be + 6); }
        if (SITE(8) && IN(be + 7)) { NEWCTX(); for (int rep_ = 0; rep_ < REPS(8); ++rep_) {
            pg8::Gemm g{WSP(bf16_t, WS_H), WSP(bf16_t, WS_WGU + j * SZ_WGU), T, 2 * DFF, D}; pg8::StaticOrder S; S.init(T, 2 * DFF, a.G, a.bx);
            pg8::EpiSwiglu E{WSP(bf16_t, WS_HFF), DFF, 2 * DFF / 256};
            pg8::gemm_phase<pg8::EpiSwiglu, pg8::StaticOrder, true, true>(a.L, g, S, E, TIDX(a)); } ENDPH(be + 7); }
        if (SITE(9) && IN(be + 8)) { NEWCTX(); for (int rep_ = 0; rep_ < REPS(9); ++rep_) {
            pg8::Gemm g{WSP(bf16_t, WS_HFF) + (size_t)CTX * DFF, WSP(bf16_t, WS_WDN + j * SZ_WDN), SEQ, D, DFF}; pg8::StaticOrder S; S.init(SEQ, D, a.G, a.bx);
            pg8::EpiResid E{WSP(float, WS_X1) + (size_t)CTX * D, WSP(float, WS_X) + (size_t)CTX * D, modv + ((Le * 2 + 0) * 6 + 5) * 1024, modv + ((Le * 2 + 0) * 6 + 5) * 1024};
            pg8::gemm_phase<pg8::EpiResid, pg8::StaticOrder, true, true>(a.L, g, S, E, TIDX(a));
            ctx_gemm<1>(a, WSP(bf16_t, WS_HFF), WSP(bf16_t, WS_WDN + j * SZ_WDN), DFF, D, nullptr, 0, WSP(float, WS_X1), WSP(float, WS_X), modv + ((Le * 2 + 1) * 6 + 5) * 1024, a.L); } ENDPH(be + 8); }
        if (SITE(10) && IN(bo + 0)) { NEWCTX(); for (int rep_ = 0; rep_ < REPS(10); ++rep_) { ph_rowpass<false, false, false>(a, Lo, 0); if (pr == 1) { int itb = 0; moe_weights(a, 1, a.L, itb); } } ENDPH(bo + 0); }
        if (SITE(11) && IN(bo + 1)) { NEWCTX(); for (int rep_ = 0; rep_ < REPS(11); ++rep_) {
            pg8::Gemm g{WSP(bf16_t, WS_H) + (size_t)CTX * D, WSP(bf16_t, WS_WQKV + j * SZ_WQKV), SEQ, DQKV, D}; pg8::StaticOrder S; S.init(SEQ, DQKV, a.G, a.bx);
            pg8::EpiQkvRope E{WSP(bf16_t, WS_QR), WSP(bf16_t, WS_KR), WSP(bf16_t, WS_PROJ) + (size_t)CTX * DQKV, WSP(float, WS_SMALL + SM_ROPE), WSP(unsigned, WS_CTL) + CW_KB + j * 128};
            pg8::gemm_phase<pg8::EpiQkvRope, pg8::StaticOrder, true, true>(a.L, g, S, E, TIDX(a));
            ctx_gemm<3>(a, WSP(bf16_t, WS_H), WSP(bf16_t, WS_WQKV + j * SZ_WQKV), D, DQKV, WSP(bf16_t, WS_PROJ), DQKV, (const float*)(WSP(unsigned, WS_CTL) + CW_KB + j * 128), (float*)WSP(bf16_t, WS_QR), (const float*)WSP(bf16_t, WS_KR), a.L); } ENDPH2(bo + 1); }
        if (SITE(13) && IN(bo + 3)) { NEWCTX(); for (int rep_ = 0; rep_ < REPS(13); ++rep_) {
#ifdef PROBE_VARIANT
            if (a.p->variant != 0) ph_attn<PROBE_VARIANT>(a, j, a.L); else
#endif
            ph_attn<0>(a, j, a.L); } ENDPH(bo + 3); }
        if (SITE(14) && IN(bo + 4)) { NEWCTX(); for (int rep_ = 0; rep_ < REPS(14); ++rep_) {
            pg8::Gemm g{WSP(bf16_t, WS_MIX) + (size_t)CTX * D, WSP(bf16_t, WS_WAO + j * SZ_WSQ), SEQ, D, D}; pg8::StaticOrder S; S.init(SEQ, D, a.G, a.bx);
            pg8::EpiResid E{WSP(float, WS_X) + (size_t)CTX * D, WSP(float, WS_X1) + (size_t)CTX * D, modv + ((Lo * 2 + 0) * 6 + 2) * 1024, modv + ((Lo * 2 + 0) * 6 + 2) * 1024};
            pg8::gemm_phase<pg8::EpiResid, pg8::StaticOrder, true, true>(a.L, g, S, E, TIDX(a));
            ctx_gemm<1>(a, WSP(bf16_t, WS_MIX), WSP(bf16_t, WS_WAO + j * SZ_WSQ), D, D, nullptr, 0, WSP(float, WS_X), WSP(float, WS_X1), modv + ((Lo * 2 + 1) * 6 + 2) * 1024, a.L); } ENDPH(bo + 4); }
        if (SITE(15) && IN(bo + 5)) { NEWCTX(); for (int rep_ = 0; rep_ < REPS(15); ++rep_) { ph_rowpass<false, true, false>(a, Lo, 1); } ENDPH(bo + 5); }
        if (SITE(16) && IN(bo + 6)) { NEWCTX(); for (int rep_ = 0; rep_ < REPS(16); ++rep_) { ph_moe_assign(a, j); } ENDPH(bo + 6); }
        if (SITE(17) && IN(bo + 7)) { NEWCTX(); for (int rep_ = 0; rep_ < REPS(17); ++rep_) {
            pg8::Gemm g{WSP(bf16_t, WS_AG), WSP(bf16_t, WS_MGU), NR_MAX, 2 * EFF, D / 2}; pg8::MoeOrder S{moetab, 2 * EFF / 256, a.G, a.bx};
            pg8::EpiSwigluF8 E{WSP(unsigned char, WS_HM), EFF, 2 * EFF / 256, 1.0f / (F8_SH * F8_SW)};
            pg8::gemm_phase<pg8::EpiSwigluF8, pg8::MoeOrder, true, true>(a.L, g, S, E, TIDX(a)); } ENDPH(bo + 7); }
        if (SITE(18) && IN(bo + 8)) { NEWCTX(); for (int rep_ = 0; rep_ < REPS(18); ++rep_) {
            pg8::Gemm g{WSP(bf16_t, WS_HM), WSP(bf16_t, WS_MDN), NR_MAX, D, EFF / 2}; pg8::MoeOrder S{moetab, D / 256, a.G, a.bx};
            pg8::EpiStoreBf16S E{WSP(bf16_t, WS_Y), D, D / 256, 1.0f / (F8_SM * F8_SW)};
            pg8::gemm_phase<pg8::EpiStoreBf16S, pg8::MoeOrder, true, true>(a.L, g, S, E, TIDX(a)); } ENDPH(bo + 8); }
    }
    if (SITE(19) && IN(37)) { NEWCTX(); for (int rep_ = 0; rep_ < REPS(19); ++rep_) { ph_rowpass<true, false, true>(a, 3, 0); } }
#undef IN
#undef modv
#undef moetab
#undef ENDPH
#undef SEAM
}

#ifdef CPU_SIM
#ifndef SIM_GRID
#define SIM_GRID 16
#endif
int g_sim_ph_lo = 0, g_sim_ph_hi = N_PHASES;
extern "C" void kernel_launch(void* const* d_in, const int* in_sizes, int n_in, void* d_out, int out_size, void* d_ws, size_t ws_size, hipStream_t stream) {
    KArgs a{}; for (int i = 0; i < 26; ++i) a.in[i] = (const float*)d_in[i]; a.out = (float*)d_out; a.ws = (unsigned char*)d_ws;
    if (g_sim_ph_lo == 0) memset((char*)d_ws + WS_CTL, 0, CTL_BYTES);
    for (int p = g_sim_ph_lo; p < g_sim_ph_hi; ++p) { KArgs ap = a; ap.ph_lo = p; ap.ph_hi = p + 1;
        pg8::g_cur_phase = p; { static int once = 0; if (!once) { once = 1; const char* e = getenv("FP8_MASK"); if (e) pg8::g_fp8_mask = strtoull(e, nullptr, 0); const char* ea = getenv("FP8_SA"); if (ea) pg8::g_fp8_sa = atof(ea); const char* eb = getenv("FP8_SB"); if (eb) pg8::g_fp8_sb = atof(eb); fprintf(stderr, "[sim] fp8 mask %llx sa %g sb %g\n", pg8::g_fp8_mask, pg8::g_fp8_sa, pg8::g_fp8_sb); } }
        sim_launch([&]() { fwd_kernel(ap); }, SIM_GRID, NTHR, LDS_BYTES, 8); }
}
#else
extern "C" void kernel_launch(void* const* d_in, const int* in_sizes, int n_in, void* d_out, int out_size, void* d_ws, size_t ws_size, hipStream_t stream) {
    static int grid = 0;
    if (grid == 0) {
        if (n_in != 26 || out_size != SEQ * D || ws_size < WS_END) { fprintf(stderr, "kernel_launch: unexpected shapes (n_in %d out %d ws %zu need %zu)\n", n_in, out_size, ws_size, (size_t)WS_END); grid = -1; return; }
        int dev = 0, cus = 0;
        if (hipGetDevice(&dev) != hipSuccess || hipDeviceGetAttribute(&cus, hipDeviceAttributeMultiprocessorCount, dev) != hipSuccess) { grid = -1; return; }
        if (hipFuncSetAttribute((const void*)fwd_kernel, hipFuncAttributeMaxDynamicSharedMemorySize, LDS_BYTES) != hipSuccess) { fprintf(stderr, "kernel_launch: hipFuncSetAttribute failed\n"); grid = -1; return; }
        int per_cu = 0;
        if (hipOccupancyMaxActiveBlocksPerMultiprocessor(&per_cu, (const void*)fwd_kernel, NTHR, LDS_BYTES) != hipSuccess || per_cu < 1) fprintf(stderr, "kernel_launch: occupancy query says %d\n", per_cu);
        (void)hipGetLastError();
        grid = cus;
    }
    if (grid < 0) return;
    (void)hipMemsetAsync((char*)d_ws + WS_CTL, 0, CTL_BYTES, stream);
    KArgs a{};
    for (int i = 0; i < 26; ++i) a.in[i] = (const float*)d_in[i];
    a.out = (float*)d_out; a.ws = (unsigned char*)d_ws;
#if N_LAUNCH_MODE == 0 && defined(PROBE_PHASE) && defined(PROBE_VARIANT)
    a.variant = 0; a.ph_lo = 0; a.ph_hi = PROBE_PHASE;
    hipLaunchKernelGGL(fwd_kernel, dim3(grid), dim3(NTHR), LDS_BYTES, stream, a);
    for (int r = 1; r < PROBE_REPS; ++r) { (void)hipMemsetAsync((char*)d_ws + WS_CTL + CW_BAR * 4, 0, XCD_BAR_WORDS * 4, stream); a.variant = 1; a.ph_lo = PROBE_PHASE; a.ph_hi = PROBE_PHASE + 1;
        hipLaunchKernelGGL(fwd_kernel, dim3(grid), dim3(NTHR), LDS_BYTES, stream, a); }
    (void)hipMemsetAsync((char*)d_ws + WS_CTL + CW_BAR * 4, 0, XCD_BAR_WORDS * 4, stream); a.variant = 0; a.ph_lo = PROBE_PHASE; a.ph_hi = N_PHASES;
    hipLaunchKernelGGL(fwd_kernel, dim3(grid), dim3(NTHR), LDS_BYTES, stream, a);
#elif N_LAUNCH_MODE == 0 && defined(PROBE_PHASE)
    a.ph_lo = 0; a.ph_hi = PROBE_PHASE + 1;
    hipLaunchKernelGGL(fwd_kernel, dim3(grid), dim3(NTHR), LDS_BYTES, stream, a);
    for (int r = 1; r < PROBE_REPS; ++r) { (void)hipMemsetAsync((char*)d_ws + WS_CTL + CW_BAR * 4, 0, XCD_BAR_WORDS * 4, stream); a.ph_lo = PROBE_PHASE; a.ph_hi = PROBE_PHASE + 1;
        hipLaunchKernelGGL(fwd_kernel, dim3(grid), dim3(NTHR), LDS_BYTES, stream, a); }
    if (PROBE_PHASE + 1 < N_PHASES) { (void)hipMemsetAsync((char*)d_ws + WS_CTL + CW_BAR * 4, 0, XCD_BAR_WORDS * 4, stream); a.ph_lo = PROBE_PHASE + 1; a.ph_hi = N_PHASES;
        hipLaunchKernelGGL(fwd_kernel, dim3(grid), dim3(NTHR), LDS_BYTES, stream, a); }
#elif N_LAUNCH_MODE == 0
    a.ph_lo = 0; a.ph_hi = N_PHASES;
    hipLaunchKernelGGL(fwd_kernel, dim3(grid), dim3(NTHR), LDS_BYTES, stream, a);
#else
    for (int p = 0; p < N_PHASES; ++p) { a.ph_lo = p; a.ph_hi = p + 1; hipLaunchKernelGGL(fwd_kernel, dim3(grid), dim3(NTHR), LDS_BYTES, stream, a); }
#endif
}
#endif
```
